# Optimizing an MI355X kernel written in HIP

```python
import math
import jax, jax.numpy as jnp
from jax import lax
import numpy as np

D_MODEL = 1024
BATCH = 2
SEQ = 8192
DEPTH = 1
DEC_BATCH = 16
DEC_SEQ = 32
PAST_LEN = 2048

CHUNK = 64
Q_BLOCK = 128
H_A = 8
DH_A = 64
DV_A = 2 * DH_A
W_A = H_A * DV_A
H_M = 4
DH_M = D_MODEL // H_M
W_M = H_M * DH_M
D_FF = 2816
CONV_W = 3
EPS = 1e-6
COL_SIZES = (W_A, W_A, W_A, W_M, W_M, W_M, H_M, H_M, W_M, D_MODEL, D_MODEL)
D_IN = 3 * W_A + 4 * W_M + 2 * H_M + 2 * D_MODEL

kernel_name = 'diffattn_mlstm_convffn_stream_step'


def _split_points():
    return [int(v) for v in np.cumsum(COL_SIZES)[:-1]]


def _rmsnorm(x, g):
    xf = x.astype(jnp.float32)
    y = xf * lax.rsqrt(jnp.mean(xf * xf, axis=-1, keepdims=True) + EPS)
    return (y * g.astype(jnp.float32)).astype(x.dtype)


def _diff_softmax_mix(q, k, v, lam, mask):
    s = jnp.einsum('bqhmd,bkhmd->bmhqk', q, k).astype(jnp.float32) * (DH_A ** -0.5)
    if mask is not None:
        s = jnp.where(mask, s, -jnp.inf)
    p = jax.nn.softmax(s, axis=-1)
    a = p[:, 0] - lam * p[:, 1]
    return jnp.einsum('bhqk,bkhd->bqhd', a.astype(v.dtype), v)


def _diff_attn_prompt(q, k, v, lam):
    B, S = q.shape[:2]
    nb = S // Q_BLOCK
    qb = jnp.moveaxis(q.reshape(B, nb, Q_BLOCK, H_A, 2, DH_A), 1, 0)
    k_chunk = jnp.arange(S) // CHUNK

    def one_block(args):
        q_blk, i = args
        q_chunk = (i * Q_BLOCK + jnp.arange(Q_BLOCK)) // CHUNK
        mask = k_chunk[None, :] <= q_chunk[:, None]
        return _diff_softmax_mix(q_blk, k, v, lam, mask)

    o = lax.map(one_block, (qb, jnp.arange(nb)))
    return jnp.moveaxis(o, 0, 1).reshape(B, S, H_A, DV_A)


def _mlstm_chunk(state, xs):
    C, n, m = state
    q, k, v, ig, lf = xs
    T = q.shape[1]
    b = jnp.cumsum(lf, axis=1)
    d = b[:, :, None, :] - b[:, None, :, :] + ig[:, None, :, :]
    causal = jnp.tril(jnp.ones((T, T), dtype=bool))
    d = jnp.where(causal[None, :, :, None], d, -jnp.inf)
    inter = b + m[:, None, :]
    m_t = jnp.maximum(inter, jnp.max(d, axis=2))
    w_intra = jnp.exp(d - m_t[:, :, None, :])
    w_inter = jnp.exp(inter - m_t)
    qs = q * (DH_M ** -0.5)
    s = jnp.einsum('bthd,bshd->btsh', qs, k) * w_intra
    num = jnp.einsum('btsh,bshd->bthd', s, v) + w_inter[..., None] * jnp.einsum('bhvd,bthd->bthv', C, qs)
    den = jnp.sum(s, axis=2) + w_inter * jnp.einsum('bhd,bthd->bth', n, qs)
    h = num / jnp.maximum(jnp.abs(den), jnp.exp(-m_t))[..., None]
    g_last = b[:, -1, :]
    logw = g_last[:, None, :] - b + ig
    m_new = jnp.maximum(g_last + m, jnp.max(logw, axis=1))
    ws = jnp.exp(logw - m_new[:, None, :])
    wc = jnp.exp(g_last + m - m_new)
    C_new = wc[..., None, None] * C + jnp.einsum('bsh,bshv,bshd->bhvd', ws, v, k)
    n_new = wc[..., None] * n + jnp.einsum('bsh,bshd->bhd', ws, k)
    return (C_new, n_new, m_new), h


def _mlstm(q, k, v, ig, lf, state):
    B, L = q.shape[:2]
    T = min(CHUNK, L)
    nc = L // T

    def to_chunks(a):
        a = a.astype(jnp.float32)
        return jnp.moveaxis(a.reshape((B, nc, T) + a.shape[2:]), 1, 0)

    xs = tuple(to_chunks(a) for a in (q, k, v, ig, lf))
    state = tuple(s.astype(jnp.float32) for s in state)
    state, h = lax.scan(_mlstm_chunk, state, xs)
    h = jnp.moveaxis(h, 0, 1).reshape(B, L, H_M, DH_M)
    return h.astype(q.dtype), state


def _layer(x, cache_k, cache_v, C0, n0, m0, conv0, g_pre_mix, w_in, b_gates, lam_q1, lam_k1,
           lam_q2, lam_k2, g_attn_head, g_mlstm_head, w_out, g_post_mix, g_pre_ffn, w_up,
           conv_w, conv_b, w_down, g_post_ffn, lam_init):
    B, L, _ = x.shape
    h = _rmsnorm(x, g_pre_mix)
    z = h @ w_in
    qa, ka, va, qm, km, vm, ig, fg, om, ga, gm = jnp.split(z, _split_points(), axis=-1)

    qa = qa.reshape(B, L, H_A, 2, DH_A)
    ka = ka.reshape(B, L, H_A, 2, DH_A)
    va = va.reshape(B, L, H_A, DV_A)
    f32 = jnp.float32
    lam = (jnp.exp(jnp.sum(lam_q1.astype(f32) * lam_k1.astype(f32)))
           - jnp.exp(jnp.sum(lam_q2.astype(f32) * lam_k2.astype(f32))) + lam_init)
    if cache_k is None:
        attn = _diff_attn_prompt(qa, ka, va, lam)
    else:
        P = cache_k.shape[1]
        k_all = jnp.concatenate([cache_k.reshape(B, P, H_A, 2, DH_A).astype(ka.dtype), ka], axis=1)
        v_all = jnp.concatenate([cache_v.astype(va.dtype), va], axis=1)
        attn = _diff_softmax_mix(qa, k_all, v_all, lam, None)
    attn = (_rmsnorm(attn, g_attn_head) * (1.0 - lam_init)).reshape(B, L, W_A)

    ig = ig + b_gates[:H_M]
    lf = jax.nn.log_sigmoid((fg + b_gates[H_M:]).astype(f32))
    hm, (C1, n1, m1) = _mlstm(qm.reshape(B, L, H_M, DH_M), km.reshape(B, L, H_M, DH_M),
                              vm.reshape(B, L, H_M, DH_M), ig, lf, (C0, n0, m0))
    hm = jax.nn.sigmoid(om) * _rmsnorm(hm, g_mlstm_head).reshape(B, L, W_M)

    merged = jax.nn.sigmoid(ga) * attn + jax.nn.sigmoid(gm) * hm
    x = x + _rmsnorm(merged @ w_out, g_post_mix)

    h2 = _rmsnorm(x, g_pre_ffn)
    u, g = jnp.split(h2 @ w_up, 2, axis=-1)
    gp = jnp.concatenate([conv0.astype(g.dtype), g], axis=1)
    gc = conv_b + sum(conv_w[j] * gp[:, j:j + L] for j in range(CONV_W))
    ff = (jax.nn.gelu(gc) * u) @ w_down
    x = x + _rmsnorm(ff, g_post_ffn)

    new_k = ka.reshape(B, L, H_A, 2 * DH_A)
    return (x, new_k, va, C1.astype(x.dtype), n1.astype(x.dtype), m1.astype(x.dtype),
            gp[:, L:])


def setup_inputs(seed: int = 0) -> dict:
    key = jax.random.key(seed)
    ks = jax.random.split(key, 32)
    f32 = jnp.float32

    def nrm(k, shape, s):
        return jax.random.normal(k, shape, f32) * s

    def gain(k, shape):
        return 1.0 + nrm(k, shape, 0.01)

    b_i = nrm(ks[20], (DEPTH, H_M), 0.1)
    b_f = jnp.linspace(3.0, 6.0, H_M, dtype=f32)[None, :] + nrm(ks[21], (DEPTH, H_M), 0.1)
    return {
        'x_prompt': nrm(ks[0], (BATCH, SEQ, D_MODEL), 1.0),
        'x_sample': nrm(ks[1], (DEC_BATCH, DEC_SEQ, D_MODEL), 1.0),
        'cache_k': nrm(ks[2], (DEPTH, DEC_BATCH, PAST_LEN, H_A, 2 * DH_A), 1.0),
        'cache_v': nrm(ks[3], (DEPTH, DEC_BATCH, PAST_LEN, H_A, DV_A), 1.0),
        'state_C': nrm(ks[4], (DEPTH, DEC_BATCH, H_M, DH_M, DH_M), 1.0),
        'state_n': nrm(ks[5], (DEPTH, DEC_BATCH, H_M, DH_M), 2.0),
        'state_m': 3.0 + nrm(ks[6], (DEPTH, DEC_BATCH, H_M), 0.5),
        'state_conv': nrm(ks[7], (DEPTH, DEC_BATCH, CONV_W - 1, D_FF), 1.0),
        'g_pre_mix': gain(ks[8], (DEPTH, D_MODEL)),
        'w_in': nrm(ks[9], (DEPTH, D_MODEL, D_IN), D_MODEL ** -0.5),
        'b_gates': jnp.concatenate([b_i, b_f], axis=-1),
        'lam_q1': nrm(ks[10], (DEPTH, DH_A), 0.1),
        'lam_k1': nrm(ks[11], (DEPTH, DH_A), 0.1),
        'lam_q2': nrm(ks[12], (DEPTH, DH_A), 0.1),
        'lam_k2': nrm(ks[13], (DEPTH, DH_A), 0.1),
        'g_attn_head': gain(ks[14], (DEPTH, DV_A)),
        'g_mlstm_head': gain(ks[15], (DEPTH, H_M, DH_M)),
        'w_out': nrm(ks[16], (DEPTH, D_MODEL, D_MODEL), D_MODEL ** -0.5),
        'g_post_mix': gain(ks[17], (DEPTH, D_MODEL)),
        'g_pre_ffn': gain(ks[18], (DEPTH, D_MODEL)),
        'w_up': nrm(ks[19], (DEPTH, D_MODEL, 2 * D_FF), D_MODEL ** -0.5),
        'conv_w': nrm(ks[22], (DEPTH, CONV_W, D_FF), CONV_W ** -0.5),
        'conv_b': nrm(ks[23], (DEPTH, D_FF), 0.01),
        'w_down': nrm(ks[24], (DEPTH, D_FF, D_MODEL), D_FF ** -0.5),
        'g_post_ffn': gain(ks[25], (DEPTH, D_MODEL)),
    }


def reference(x_prompt, x_sample, cache_k, cache_v, state_C, state_n, state_m, state_conv,
              g_pre_mix, w_in, b_gates, lam_q1, lam_k1, lam_q2, lam_k2, g_attn_head,
              g_mlstm_head, w_out, g_post_mix, g_pre_ffn, w_up, conv_w, conv_b, w_down,
              g_post_ffn):
    yp, ys = x_prompt, x_sample
    Bp = x_prompt.shape[0]
    dt = x_prompt.dtype
    outs_p, outs_s = [], []
    for l in range(DEPTH):
        lam_init = 0.8 - 0.6 * math.exp(-0.3 * l)
        w = (g_pre_mix[l], w_in[l], b_gates[l], lam_q1[l], lam_k1[l], lam_q2[l], lam_k2[l],
             g_attn_head[l], g_mlstm_head[l], w_out[l], g_post_mix[l], g_pre_ffn[l], w_up[l],
             conv_w[l], conv_b[l], w_down[l], g_post_ffn[l])
        C0 = jnp.zeros((Bp, H_M, DH_M, DH_M), dt)
        n0 = jnp.zeros((Bp, H_M, DH_M), dt)
        m0 = jnp.zeros((Bp, H_M), dt)
        conv0 = jnp.zeros((Bp, CONV_W - 1, D_FF), dt)
        yp, *sp = _layer(yp, None, None, C0, n0, m0, conv0, *w, lam_init)
        ys, *ss = _layer(ys, cache_k[l], cache_v[l], state_C[l], state_n[l], state_m[l],
                         state_conv[l], *w, lam_init)
        outs_p.append(sp)
        outs_s.append(ss)
    k_p, v_p, C_p, n_p, m_p, conv_p = [jnp.stack([o[i] for o in outs_p]) for i in range(6)]
    k_s, v_s, C_s, n_s, m_s, conv_s = [jnp.stack([o[i] for o in outs_s]) for i in range(6)]
    return (yp, ys, k_p, v_p, C_p, n_p, m_p, conv_p, k_s, v_s, C_s, n_s, m_s, conv_s)
```

```cpp
#include <hip/hip_runtime.h>
#include <hip/hip_cooperative_groups.h>
#include <hip/hip_bf16.h>
#include <cstdio>
#include <cstdint>
#include <cmath>
namespace cg = cooperative_groups;
namespace pg8 {
#define PG8_LAS __attribute__((address_space(3)))
typedef unsigned short bf16_t;
typedef short bf16x8 __attribute__((ext_vector_type(8)));
typedef float f32x4 __attribute__((ext_vector_type(4)));
typedef unsigned u32x4 __attribute__((ext_vector_type(4)));
constexpr int BM = 256, BK = 64, HALF = 128, HTB = HALF * BK * 2  , STAGE_BYTES = 8 * HTB, NXCD = 8, WGM = 8;

__host__ __device__ __forceinline__ int lds_byte(int r, int c) { const int st = (r >> 4) * 2 + (c >> 5), rr = r & 15, cc = c & 31, ob = rr * 64 + cc * 2; return st * 1024 + (ob ^ (((ob >> 9) & 1) << 5)); }
__host__ __device__ __forceinline__ void stage_rc(int b, int& R, int& C) { const int st = b / 1024, sb = b % 1024, swz = sb ^ (((sb >> 9) & 1) << 5); R = (st >> 1) * 16 + swz / 64; C = (st & 1) * 32 + (swz % 64) / 2; }
__host__ __device__ __forceinline__ int perm32(int rho) { const int n = rho >> 4, i = rho & 15; return 8 * (i >> 2) + 4 * n + (i & 3); }

struct Unit { int pm, pn; };
struct Gemm { const bf16_t* A; const bf16_t* Bt; int M, N, K; };

struct StaticOrder {
    int nM, nN, nwg, G, c;
    __host__ __device__ void init(int M, int N, int G_, int c_) { nM = M / BM; nN = N / BM; nwg = nM * nN; G = G_; c = c_; }
    __host__ __device__ bool next(int i, Unit& u) const {
        const long L = (long)i * G + c; if (L >= nwg) return false;
        int wgid = (int)L; { const int q = nwg / NXCD, r = nwg % NXCD, xcd = wgid % NXCD, off = wgid / NXCD; wgid = (xcd < r ? xcd * (q + 1) : r * (q + 1) + (xcd - r) * q) + off; }
        const int nig = WGM * nN, gid = wgid / nig, fm = gid * WGM, gsz = (nM - fm) < WGM ? (nM - fm) : WGM;
        u.pm = fm + ((wgid % nig) % gsz); u.pn = (wgid % nig) / gsz; return true;
    }
    __device__ __forceinline__ void a_ready(const Unit&) const {}
    __device__ __forceinline__ void done(const Unit&) const {}
};

__device__ __forceinline__ unsigned cvt_pk_bf16(float lo, float hi) { unsigned r; asm volatile("v_cvt_pk_bf16_f32 %0, %1, %2" : "=v"(r) : "v"(lo), "v"(hi)); return r; }
typedef float f32x2 __attribute__((ext_vector_type(2)));
__device__ __forceinline__ f32x2 gelu_pk(f32x2 v) {
    const f32x2 av = __builtin_elementwise_abs(v), d = av * 0.2316418882f + 1.0f;
    f32x2 t; t.x = __builtin_amdgcn_rcpf(d.x); t.y = __builtin_amdgcn_rcpf(d.y);
    f32x2 q = t * 0.5307027145f + (-0.7265760135f); q = q * t + 0.7107068705f; q = q * t + (-0.142248368f); q = q * t + 0.127414796f; q = q * t;
    const f32x2 s = (v * v) * (-0.72134752044f);
    f32x2 e; e.x = __builtin_amdgcn_exp2f(s.x); e.y = __builtin_amdgcn_exp2f(s.y);
    const f32x2 m = v * (q * e), r = v - m;
    f32x2 o; o.x = v.x < 0.f ? m.x : r.x; o.y = v.y < 0.f ? m.y : r.y; return o;
}

template <int ACT  > struct EpiBf16 {
    static constexpr bool PERM = true, AFTER_DRAIN = false; static_assert(ACT == 0 || ACT == 1, "EpiBf16: ACT is 0 (none) or 1 (gelu_pk)");
    bf16_t* O; int ldc; const float* bias; int split_cols; size_t split_stride; float scale0;
    __device__ __forceinline__ void operator()(const f32x4 (&acc)[2][2][4][2], const Unit& u, int wr, int wc, int fr, int fq) const {
        const int row0 = u.pm * BM + wr * 64 + fr; int colt = u.pn * BM; bf16_t* base = O;
        float sc = 1.f; if (split_cols) { const int t = colt / split_cols; base += (size_t)t * split_stride; colt -= t * split_cols; if (t == 0) sc = scale0; }
        const int col0 = colt + wc * 32 + 8 * fq, bcol0 = u.pn * BM + wc * 32 + 8 * fq;
        f32x4 bv[2][2];
#pragma unroll
        for (int bj = 0; bj < 2; ++bj)
#pragma unroll
            for (int n = 0; n < 2; ++n) bv[bj][n] = bias ? *(const f32x4*)(bias + bcol0 + bj * HALF + 4 * n) : (f32x4){0.f, 0.f, 0.f, 0.f};
#pragma unroll
        for (int ai = 0; ai < 2; ++ai)
#pragma unroll
            for (int m = 0; m < 4; ++m) { bf16_t* rowp = base + (size_t)(row0 + ai * HALF + m * 16) * ldc + col0;
#pragma unroll
                for (int bj = 0; bj < 2; ++bj) { f32x4 v0 = acc[ai][bj][m][0] + bv[bj][0], v1 = acc[ai][bj][m][1] + bv[bj][1];
                    if (ACT == 1) { f32x2 a = gelu_pk((f32x2){v0[0], v0[1]}), b = gelu_pk((f32x2){v0[2], v0[3]}), c = gelu_pk((f32x2){v1[0], v1[1]}), d = gelu_pk((f32x2){v1[2], v1[3]});
                        v0 = (f32x4){a.x, a.y, b.x, b.y}; v1 = (f32x4){c.x, c.y, d.x, d.y}; }
                    v0 = v0 * sc; v1 = v1 * sc; u32x4 w; w.x = cvt_pk_bf16(v0[0], v0[1]); w.y = cvt_pk_bf16(v0[2], v0[3]); w.z = cvt_pk_bf16(v1[0], v1[1]); w.w = cvt_pk_bf16(v1[2], v1[3]);
                    *(u32x4*)(rowp + bj * HALF) = w; } }
    }
};

struct PanelStats {
    unsigned* xbuf;
    unsigned* cnt;
    unsigned* tmo;
    int ntn; float eps;
    unsigned code;
    __device__ __forceinline__ bool run(const f32x4 (&v)[2][2][4][2], const Unit& u, int wr, int wc, int fr, int fq, PG8_LAS unsigned char* lds, int wid, int lane) const {
        typedef float f32x2v __attribute__((ext_vector_type(2)));
        PG8_LAS f32x2v* P = (PG8_LAS f32x2v*)lds;
        PG8_LAS f32x2v* S = (PG8_LAS f32x2v*)(lds + 8192);
        PG8_LAS unsigned* flag = (PG8_LAS unsigned*)(lds + 8192 + 2048);
#pragma unroll
        for (int ai = 0; ai < 2; ++ai)
#pragma unroll
            for (int m = 0; m < 4; ++m) {
                float s = 0.f;
#pragma unroll
                for (int bj = 0; bj < 2; ++bj)
#pragma unroll
                    for (int n = 0; n < 2; ++n) { const f32x4 x = v[ai][bj][m][n]; s += (x[0] + x[1]) + (x[2] + x[3]); }
                s += __shfl_xor(s, 16); s += __shfl_xor(s, 32);
                const float mw = s * (1.0f / 64.0f); float q = 0.f;
#pragma unroll
                for (int bj = 0; bj < 2; ++bj)
#pragma unroll
                    for (int n = 0; n < 2; ++n) { const f32x4 d = v[ai][bj][m][n] - mw; q += (d[0] * d[0] + d[1] * d[1]) + (d[2] * d[2] + d[3] * d[3]); }
                q += __shfl_xor(q, 16); q += __shfl_xor(q, 32);
                if (fq == 0) P[(ai * HALF + wr * 64 + m * 16 + fr) * 4 + wc] = (f32x2v){mw, q};
            }
        asm volatile("s_waitcnt lgkmcnt(0)" ::: "memory"); __builtin_amdgcn_s_barrier(); asm volatile("" ::: "memory");
#if defined(BROKEN_EXCHANGE_NO_WAIT)
#warning BROKEN CONTROL BUILD: the row-statistics exchange does not wait; results are wrong by design
        if (blockIdx.x >= 64) { const long long t0_ = clock64(); while (clock64() - t0_ < 60000) __builtin_amdgcn_s_sleep(8); }
#endif
        const int row = wid * 32 + (lane & 31);
        if (lane < 32) {
            const f32x2v a = P[row * 4 + 0], b = P[row * 4 + 1], c = P[row * 4 + 2], d = P[row * 4 + 3];
            const float mt = (a.x + b.x + c.x + d.x) * 0.25f;
            const float da = a.x - mt, db = b.x - mt, dc = c.x - mt, dd = d.x - mt;
            const float m2 = (a.y + b.y) + (c.y + d.y) + 64.0f * ((da * da + db * db) + (dc * dc + dd * dd));
            unsigned long long* slot = (unsigned long long*)xbuf + ((size_t)(u.pm * BM + row) * 4 + u.pn);
            __hip_atomic_store(slot, ((unsigned long long)__float_as_uint(m2) << 32) | __float_as_uint(mt), __ATOMIC_RELAXED, __HIP_MEMORY_SCOPE_AGENT);
        }
        asm volatile("s_waitcnt vmcnt(0)" ::: "memory");
        if (lane == 0) __hip_atomic_fetch_add(cnt + 64 * u.pm, 1u, __ATOMIC_RELAXED, __HIP_MEMORY_SCOPE_AGENT);
        if (wid == 0) {
            bool dead = false; const unsigned long long t0 = __builtin_amdgcn_s_memrealtime(); const unsigned want = 8u * (unsigned)ntn;
            for (;;) {
#if defined(BROKEN_EXCHANGE_NO_WAIT)
                break;
#endif
                if ((unsigned)__builtin_amdgcn_readfirstlane(__hip_atomic_load(cnt + 64 * u.pm, __ATOMIC_RELAXED, __HIP_MEMORY_SCOPE_AGENT)) >= want) break;
                if (__builtin_amdgcn_s_memrealtime() - t0 > 2000000ull) {
                    if (lane == 0) { unsigned expect = 0u; __hip_atomic_compare_exchange_strong(tmo + 1, &expect, code | (unsigned)(u.pm & 0xff), __ATOMIC_RELAXED, __ATOMIC_RELAXED, __HIP_MEMORY_SCOPE_AGENT);
                                     __hip_atomic_store(tmo, 1u, __ATOMIC_RELAXED, __HIP_MEMORY_SCOPE_AGENT); }
                    dead = true; break; }
                __builtin_amdgcn_s_sleep(2);
            }
            __builtin_amdgcn_fence(__ATOMIC_ACQUIRE, "agent");
            if (lane == 0) flag[0] = dead ? 1u : 0u;
        }
        asm volatile("s_waitcnt vmcnt(0) lgkmcnt(0)" ::: "memory"); __builtin_amdgcn_s_barrier(); asm volatile("" ::: "memory");
        const bool bad = flag[0] != 0u;
        if (lane < 32) {
            const unsigned long long* slot = (const unsigned long long*)xbuf + (size_t)(u.pm * BM + row) * 4; float mt[4], m2[4]; float ms = 0.f;
#pragma unroll
            for (int t = 0; t < 4; ++t) { if (t < ntn) { const unsigned long long w = __hip_atomic_load(slot + t, __ATOMIC_RELAXED, __HIP_MEMORY_SCOPE_AGENT); mt[t] = __uint_as_float((unsigned)w); m2[t] = __uint_as_float((unsigned)(w >> 32)); } else { mt[t] = 0.f; m2[t] = 0.f; } ms += mt[t]; }
            const float mean = ms / (float)ntn; float q = 0.f;
#pragma unroll
            for (int t = 0; t < 4; ++t) if (t < ntn) { const float dm = mt[t] - mean; q += m2[t] + 256.0f * dm * dm; }
            S[row] = (f32x2v){mean, 1.0f / sqrtf(q / (256.0f * (float)ntn) + eps)};
        }
        asm volatile("s_waitcnt lgkmcnt(0)" ::: "memory"); __builtin_amdgcn_s_barrier(); asm volatile("" ::: "memory");
        return bad;
    }
};
struct EpiLnRes {
    static constexpr bool PERM = false, AFTER_DRAIN = true;
    const float* base; float* out; int ldc; const float* bias; PanelStats st; unsigned poison;
    __device__ __forceinline__ void fused(f32x4 (&acc)[2][2][4][2], const Unit& u, int wr, int wc, int fr, int fq, PG8_LAS unsigned char* lds, int wid, int lane) const {
        typedef float f32x2v __attribute__((ext_vector_type(2)));
        const PG8_LAS f32x2v* S = (const PG8_LAS f32x2v*)(lds + 8192);
        const int col0 = u.pn * BM + wc * 32 + 4 * fq;
#pragma unroll
        for (int bj = 0; bj < 2; ++bj)
#pragma unroll
            for (int n = 0; n < 2; ++n) { const f32x4 bv = bias ? *(const f32x4*)(bias + col0 + bj * HALF + n * 16) : (f32x4){0.f, 0.f, 0.f, 0.f};
#pragma unroll
                for (int ai = 0; ai < 2; ++ai)
#pragma unroll
                    for (int m = 0; m < 4; ++m) acc[ai][bj][m][n] += bv; }
        f32x4 pre[4][2][2];
#pragma unroll
        for (int m = 0; m < 4; ++m) { const size_t off = (size_t)(u.pm * BM + wr * 64 + m * 16 + fr) * ldc + col0;
#pragma unroll
            for (int bj = 0; bj < 2; ++bj)
#pragma unroll
                for (int n = 0; n < 2; ++n) pre[m][bj][n] = *(const f32x4*)(base + off + bj * HALF + n * 16); }
        const bool bad = st.run(acc, u, wr, wc, fr, fq, lds, wid, lane) || poison != 0u;
        const float qnan = __builtin_nanf("");
#pragma unroll
        for (int ai = 0; ai < 2; ++ai)
#pragma unroll
            for (int m = 0; m < 4; ++m) { const int r = ai * HALF + wr * 64 + m * 16 + fr; const f32x2v sr = S[r]; const size_t off = (size_t)(u.pm * BM + r) * ldc + col0;
#pragma unroll
                for (int bj = 0; bj < 2; ++bj)
#pragma unroll
                    for (int n = 0; n < 2; ++n) { const f32x4 bs = ai == 0 ? pre[m][bj][n] : *(const f32x4*)(base + off + bj * HALF + n * 16); f32x4 o = bs + (acc[ai][bj][m][n] - sr.x) * sr.y;
                        if (bad) o = (f32x4){qnan, qnan, qnan, qnan}; *(f32x4*)(out + off + bj * HALF + n * 16) = o; }
                if (m & 1) asm volatile("" ::: "memory"); }
    }
};
struct EpiLnResLn {
    static constexpr bool PERM = false, AFTER_DRAIN = true;
    const float* base; float* out; bf16_t* xn; int ldc; const float* bias; PanelStats st1, st2; unsigned poison;
    __device__ __forceinline__ void fused(f32x4 (&acc)[2][2][4][2], const Unit& u, int wr, int wc, int fr, int fq, PG8_LAS unsigned char* lds, int wid, int lane) const {
        typedef float f32x2v __attribute__((ext_vector_type(2))); typedef unsigned u32x2v __attribute__((ext_vector_type(2)));
        const PG8_LAS f32x2v* S = (const PG8_LAS f32x2v*)(lds + 8192);
        const int col0 = u.pn * BM + wc * 32 + 4 * fq;
#pragma unroll
        for (int bj = 0; bj < 2; ++bj)
#pragma unroll
            for (int n = 0; n < 2; ++n) { const f32x4 bv = bias ? *(const f32x4*)(bias + col0 + bj * HALF + n * 16) : (f32x4){0.f, 0.f, 0.f, 0.f};
#pragma unroll
                for (int ai = 0; ai < 2; ++ai)
#pragma unroll
                    for (int m = 0; m < 4; ++m) acc[ai][bj][m][n] += bv; }
        bool bad = st1.run(acc, u, wr, wc, fr, fq, lds, wid, lane) || poison != 0u;
        const float qnan = __builtin_nanf("");
#pragma unroll
        for (int ai = 0; ai < 2; ++ai)
#pragma unroll
            for (int m = 0; m < 4; ++m) { const int r = ai * HALF + wr * 64 + m * 16 + fr; const f32x2v sr = S[r]; const size_t off = (size_t)(u.pm * BM + r) * ldc + col0;
#pragma unroll
                for (int bj = 0; bj < 2; ++bj)
#pragma unroll
                    for (int n = 0; n < 2; ++n) { const f32x4 bs = *(const f32x4*)(base + off + bj * HALF + n * 16); acc[ai][bj][m][n] = bs + (acc[ai][bj][m][n] - sr.x) * sr.y; }
                asm volatile("" : "+v"(acc[ai][0][m][0]), "+v"(acc[ai][0][m][1]), "+v"(acc[ai][1][m][0]), "+v"(acc[ai][1][m][1]));
                if (m & 1) asm volatile("" ::: "memory"); }
        const bool bad1 = bad;
        bad = st2.run(acc, u, wr, wc, fr, fq, lds, wid, lane) || bad;
#pragma unroll
        for (int ai = 0; ai < 2; ++ai)
#pragma unroll
            for (int m = 0; m < 4; ++m) { const int r = ai * HALF + wr * 64 + m * 16 + fr; const f32x2v sr = S[r]; const size_t off = (size_t)(u.pm * BM + r) * ldc + col0;
#pragma unroll
                for (int bj = 0; bj < 2; ++bj)
#pragma unroll
                    for (int n = 0; n < 2; ++n) { const f32x4 x1 = acc[ai][bj][m][n]; *(f32x4*)(out + off + bj * HALF + n * 16) = bad1 ? (f32x4){qnan, qnan, qnan, qnan} : x1;
                        const f32x4 o = (x1 - sr.x) * sr.y; u32x2v w; w.x = cvt_pk_bf16(o[0], o[1]); w.y = cvt_pk_bf16(o[2], o[3]);
                        if (bad) { w.x = 0x7fc07fc0u; w.y = 0x7fc07fc0u; } *(u32x2v*)(xn + off + bj * HALF + n * 16) = w; }
                asm volatile("" ::: "memory"); }
    }
};

template <class Epi, class Sched, bool ALIGN_EPI = false, bool SP2 = false>
__device__ __forceinline__ void gemm_phase(PG8_LAS unsigned char* lds, const Gemm g, const Sched& S, const Epi& E) {
    int tid_ = threadIdx.x; asm volatile("" : "+v"(tid_));
    const int tid = tid_, wid = __builtin_amdgcn_readfirstlane(tid >> 6), lane = tid & 63, wr = wid >> 2, wc = wid & 3, fr = lane & 15, fq = lane >> 4;
    const int K = g.K, nt = K / BK;
    unsigned voffA[2], voffB[2];
#pragma unroll
    for (int i = 0; i < 2; ++i) { int R, C; stage_rc(tid * 16 + i * 8192, R, C); const int Rb = Epi::PERM ? ((R & ~31) + perm32(R & 31)) : R;
        voffA[i] = (unsigned)(R * K + C) * 2u; voffB[i] = (unsigned)(Rb * K + C) * 2u; }
    const size_t kstep = (size_t)(BK * 2);
    const size_t hstep = (size_t)HALF * K * 2;
    const size_t tstep = 2 * hstep;
    const unsigned ldsw = (unsigned)wid * 1024u;
    const int aoff = lds_byte(wr * 64 + fr, fq * 8), boff = lds_byte(wc * 32 + fr, fq * 8);
#define PG8_SA(b, h) (((b) * 2 + (h)) * HTB)
#define PG8_SB(b, h) ((4 + (b) * 2 + (h)) * HTB)
#define PG8_STAGE(bufoff, gbase, voff) do { _Pragma("unroll") for (int _i = 0; _i < 2; ++_i) \
        __builtin_amdgcn_global_load_lds((const unsigned*)((const char*)(gbase) + (voff)[_i]), (PG8_LAS unsigned*)(lds + (bufoff) + ldsw + _i * 8192), 16, 0, 0); } while (0)
#define PG8_LDA(dst, b, h) do { _Pragma("unroll") for (int m = 0; m < 4; ++m) _Pragma("unroll") for (int k = 0; k < 2; ++k) dst[m][k] = *(const PG8_LAS bf16x8*)(lds + PG8_SA(b, h) + aoff + m * 2048 + k * 1024); } while (0)
#define PG8_LDB(dst, b, h) do { _Pragma("unroll") for (int n = 0; n < 2; ++n) _Pragma("unroll") for (int k = 0; k < 2; ++k) dst[n][k] = *(const PG8_LAS bf16x8*)(lds + PG8_SB(b, h) + boff + n * 2048 + k * 1024); } while (0)
#define PG8_MMA(ai, bj, At, Bt) do { __builtin_amdgcn_s_setprio(1); _Pragma("unroll") for (int m = 0; m < 4; ++m) _Pragma("unroll") for (int n = 0; n < 2; ++n) _Pragma("unroll") for (int k = 0; k < 2; ++k) \
        acc[ai][bj][m][n] = __builtin_amdgcn_mfma_f32_16x16x32_bf16(Bt[n][k], At[m][k], acc[ai][bj][m][n], 0, 0, 0); __builtin_amdgcn_s_setprio(0); } while (0)
#define PG8_WAIT_V(n) asm volatile("s_waitcnt vmcnt(" #n ")" ::: "memory")
#define PG8_WAIT_L(n) asm volatile("s_waitcnt lgkmcnt(" #n ")" ::: "memory")
#define PG8_BAR __builtin_amdgcn_s_barrier()
#define PG8_SCHED __builtin_amdgcn_sched_barrier(0)
    Unit cur, nxt; int ui = 0;
    if (!S.next(0, cur)) return;
    f32x4 acc[2][2][4][2];
#pragma unroll
    for (int a = 0; a < 2; ++a)
#pragma unroll
        for (int b = 0; b < 2; ++b)
#pragma unroll
            for (int m = 0; m < 4; ++m)
#pragma unroll
                for (int n = 0; n < 2; ++n) acc[a][b][m][n] = (f32x4){0.f, 0.f, 0.f, 0.f};
    bf16x8 At[4][2], B0[2][2], B1[2][2];
    const char* cA = (const char*)g.A + (size_t)cur.pm * tstep; const char* cB = (const char*)g.Bt + (size_t)cur.pn * tstep;
    S.a_ready(cur);
    if constexpr (SP2) {
        PG8_STAGE(PG8_SB(0, 0), cB, voffB); PG8_STAGE(PG8_SB(0, 1), cB + hstep, voffB); PG8_STAGE(PG8_SA(0, 0), cA, voffA); PG8_STAGE(PG8_SA(0, 1), cA + hstep, voffA);
        if (wr == 1) PG8_BAR;
        PG8_WAIT_V(2); PG8_BAR;
        PG8_STAGE(PG8_SB(1, 0), cB + kstep, voffB); PG8_STAGE(PG8_SA(1, 0), cA + kstep, voffA); PG8_STAGE(PG8_SB(1, 1), cB + hstep + kstep, voffB);
        PG8_WAIT_V(6); PG8_BAR;
    } else {
        PG8_STAGE(PG8_SB(0, 0), cB, voffB); PG8_STAGE(PG8_SA(0, 0), cA, voffA); PG8_STAGE(PG8_SB(0, 1), cB + hstep, voffB); PG8_STAGE(PG8_SA(0, 1), cA + hstep, voffA);
        if (wr == 1) PG8_BAR;
        PG8_WAIT_V(4); PG8_BAR;
        PG8_STAGE(PG8_SB(1, 0), cB + kstep, voffB); PG8_STAGE(PG8_SA(1, 0), cA + kstep, voffA); PG8_STAGE(PG8_SB(1, 1), cB + hstep + kstep, voffB);
        PG8_WAIT_V(6); PG8_BAR;
    }
    for (;;) {
        const bool has_next = S.next(ui + 1, nxt);
        const char* nA = has_next ? (const char*)g.A + (size_t)nxt.pm * tstep : cA; const char* nB = has_next ? (const char*)g.Bt + (size_t)nxt.pn * tstep : cB;
        for (int t = 0; t < nt; t += 2) {
            const bool last = (t == nt - 2);
            const char* a1 = cA + (size_t)(t + 1) * kstep;
            const char* a2 = last ? nA : cA + (size_t)(t + 2) * kstep; const char* b2 = last ? nB : cB + (size_t)(t + 2) * kstep;
            const char* a3 = a2 + kstep; const char* b3 = b2 + kstep;
            if (last && has_next) S.a_ready(nxt);
            if constexpr (SP2) {
            PG8_LDB(B0, 0, 0); PG8_LDB(B1, 0, 1); PG8_SCHED; PG8_LDA(At, 0, 0); PG8_STAGE(PG8_SA(1, 1), a1 + hstep, voffA);
            PG8_WAIT_V(8); PG8_WAIT_L(0); PG8_BAR; PG8_MMA(0, 0, At, B0); PG8_MMA(0, 1, At, B1); PG8_BAR; PG8_SCHED;
            PG8_LDA(At, 0, 1); PG8_STAGE(PG8_SB(0, 0), b2, voffB); PG8_STAGE(PG8_SB(0, 1), b2 + hstep, voffB); PG8_STAGE(PG8_SA(0, 0), a2, voffA);
            PG8_WAIT_V(8); PG8_WAIT_L(0); PG8_BAR; PG8_MMA(1, 0, At, B0); PG8_MMA(1, 1, At, B1); PG8_BAR; PG8_SCHED;
            PG8_LDB(B0, 1, 0); PG8_LDB(B1, 1, 1); PG8_SCHED; PG8_LDA(At, 1, 0); PG8_STAGE(PG8_SA(0, 1), a2 + hstep, voffA);
            PG8_WAIT_V(8); PG8_WAIT_L(0); PG8_BAR; PG8_MMA(0, 0, At, B0); PG8_MMA(0, 1, At, B1); PG8_BAR; PG8_SCHED;
            PG8_LDA(At, 1, 1); PG8_STAGE(PG8_SB(1, 0), b3, voffB); PG8_STAGE(PG8_SB(1, 1), b3 + hstep, voffB); PG8_STAGE(PG8_SA(1, 0), a3, voffA);
            PG8_WAIT_V(8); PG8_WAIT_L(0); PG8_BAR; PG8_MMA(1, 0, At, B0); PG8_MMA(1, 1, At, B1); PG8_BAR; PG8_SCHED;
            } else {
            PG8_LDB(B0, 0, 0); PG8_SCHED; PG8_LDA(At, 0, 0); PG8_STAGE(PG8_SA(1, 1), a1 + hstep, voffA);
            PG8_WAIT_L(8); PG8_BAR; PG8_WAIT_L(0); PG8_MMA(0, 0, At, B0); PG8_BAR; PG8_SCHED;
            PG8_LDB(B1, 0, 1); PG8_STAGE(PG8_SB(0, 0), b2, voffB);
            PG8_BAR; PG8_WAIT_L(0); PG8_MMA(0, 1, At, B1); PG8_BAR;
            PG8_LDA(At, 0, 1); PG8_STAGE(PG8_SA(0, 0), a2, voffA);
            PG8_BAR; PG8_WAIT_L(0); PG8_MMA(1, 0, At, B0); PG8_BAR; PG8_SCHED;
            PG8_STAGE(PG8_SB(0, 1), b2 + hstep, voffB);
            PG8_WAIT_V(6); PG8_BAR; PG8_MMA(1, 1, At, B1); PG8_BAR;
            PG8_LDB(B0, 1, 0); PG8_SCHED; PG8_LDA(At, 1, 0); PG8_STAGE(PG8_SA(0, 1), a2 + hstep, voffA);
            PG8_WAIT_L(8); PG8_BAR; PG8_WAIT_L(0); PG8_MMA(0, 0, At, B0); PG8_BAR; PG8_SCHED;
            PG8_LDB(B1, 1, 1); PG8_STAGE(PG8_SB(1, 0), b3, voffB);
            PG8_BAR; PG8_WAIT_L(0); PG8_MMA(0, 1, At, B1); PG8_BAR;
            PG8_LDA(At, 1, 1); PG8_STAGE(PG8_SA(1, 0), a3, voffA);
            PG8_BAR; PG8_WAIT_L(0); PG8_MMA(1, 0, At, B0); PG8_BAR; PG8_SCHED;
            PG8_STAGE(PG8_SB(1, 1), b3 + hstep, voffB);
            PG8_WAIT_V(6); PG8_BAR; PG8_MMA(1, 1, At, B1); PG8_BAR;
            }
        }
        if constexpr (ALIGN_EPI) { if (wr == 0) PG8_BAR; }
        if constexpr (!Epi::AFTER_DRAIN) { E(acc, cur, wr, wc, fr, fq); S.done(cur); }
        if (!has_next) break;
#pragma unroll
        for (int a = 0; a < 2; ++a)
#pragma unroll
            for (int b = 0; b < 2; ++b)
#pragma unroll
                for (int m = 0; m < 4; ++m)
#pragma unroll
                    for (int n = 0; n < 2; ++n) acc[a][b][m][n] = (f32x4){0.f, 0.f, 0.f, 0.f};
        cur = nxt; cA = nA; cB = nB; ++ui;
        if constexpr (ALIGN_EPI) { if (wr == 1) PG8_BAR; }
    }
    PG8_WAIT_V(0);
    if constexpr (!ALIGN_EPI) { if (wr == 0) PG8_BAR; }
    PG8_BAR;
    if constexpr (Epi::AFTER_DRAIN) { E.fused(acc, cur, wr, wc, fr, fq, lds, wid, lane); S.done(cur); }
#undef PG8_SA
#undef PG8_SB
#undef PG8_STAGE
#undef PG8_LDA
#undef PG8_LDB
#undef PG8_MMA
#undef PG8_WAIT_V
#undef PG8_WAIT_L
#undef PG8_BAR
#undef PG8_SCHED
}
}

#ifndef PG8_SP2
#define PG8_SP2 true
#endif
#ifndef PG8_ALIGN
#define PG8_ALIGN true
#endif
#include <hip/hip_bf16.h>
#include <cmath>
namespace attn_body {
using bf16=__hip_bfloat16;
using bf16x8=__attribute__((ext_vector_type(8)))short;
using s16x4=__attribute__((ext_vector_type(4)))short;
using f32x16=__attribute__((ext_vector_type(16)))float;
using u32x4=__attribute__((ext_vector_type(4)))unsigned;
constexpr int BATCH=2,NHEAD=16,SEQ=8192,D=64,DM=NHEAD*D;
constexpr int NW=8,QBLK=32,QB=QBLK*NW,KVBLK=64,NQB=SEQ/QB;
constexpr int ATTN_PITCH=DM, ATTN_UNIT_ROWS=QB, OPITCH=2048;
__device__ __forceinline__ int crow(int r,int hi){return (r&3)+8*(r>>2)+4*hi;}
#define SBAR() __builtin_amdgcn_sched_barrier(0)
__device__ __forceinline__ void cmask(f32x16&p0,f32x16&p1,int jb,int qrel,int hi){
  const float NEG=-INFINITY; int kb=64*jb+4*hi;
  #pragma unroll
  for(int r=0;r<16;++r){int kv=kb+(r&3)+8*(r>>2); if(kv>qrel)p0[r]=NEG; if(kv+32>qrel)p1[r]=NEG;}
}

constexpr int NSLOT=3, SLOTB=8192;
constexpr int LDS_K=0, LDS_V=NSLOT*SLOTB, LDS_WS=2*NSLOT*SLOTB, LDS_OST=LDS_WS+NW*64*4, LDS_BYTES=LDS_OST+NW*4096;
constexpr float C2=0.125f*1.4426950408889634f;
__device__ __forceinline__ void glds16(const void*gsrc,unsigned lds_dst){unsigned keep;
  asm volatile("s_mov_b32 %0, m0\n\ts_mov_b32 m0, %2\n\ts_nop 0\n\tglobal_load_lds_dwordx4 %1, off\n\ts_mov_b32 m0, %0":"=&s"(keep):"v"(gsrc),"s"(lds_dst):"memory");}
__device__ __forceinline__ float max3f(float a,float b,float c){float r;asm("v_max3_f32 %0, %1, %2, %3":"=v"(r):"v"(a),"v"(b),"v"(c));return r;}
__device__ __forceinline__ float max2f(float a,float b){float r;asm("v_max_f32_e32 %0, %1, %2":"=v"(r):"v"(a),"v"(b));return r;}
__device__ __forceinline__ float fadd_s(float a,float b){float r;asm("v_add_f32_e32 %0, %1, %2":"=v"(r):"v"(a),"v"(b));return r;}
__device__ __forceinline__ float fsub_s(float a,float b){float r;asm("v_sub_f32_e32 %0, %1, %2":"=v"(r):"v"(a),"v"(b));return r;}
typedef float f32x2_t __attribute__((ext_vector_type(2))); typedef __bf16 bf16x2_t __attribute__((ext_vector_type(2)));
__device__ __forceinline__ unsigned cvtpk_s(float lo,float hi){f32x2_t v={lo,hi};bf16x2_t b=__builtin_convertvector(v,bf16x2_t);return __builtin_bit_cast(unsigned,b);}
#define WAIT_BAR(N) asm volatile("s_waitcnt vmcnt(" #N ") lgkmcnt(0)\n\ts_barrier":::"memory")

__device__ __forceinline__ void qkt(f32x16&p0,f32x16&p1,const char*Kslot,const bf16x8*qr,const f32x16&negm,int r32,int hi){
  const char*kb=Kslot+hi*1024+r32*16;
  #pragma unroll
  for(int d0=0;d0<4;++d0){
    const bf16x8 b0=*reinterpret_cast<const bf16x8*>(kb+d0*2048);
    const bf16x8 b1=*reinterpret_cast<const bf16x8*>(kb+d0*2048+512);
    if(d0==0){p0=__builtin_amdgcn_mfma_f32_32x32x16_bf16(b0,qr[0],negm,0,0,0);p1=__builtin_amdgcn_mfma_f32_32x32x16_bf16(b1,qr[0],negm,0,0,0);}
    else{p0=__builtin_amdgcn_mfma_f32_32x32x16_bf16(b0,qr[d0],p0,0,0,0);p1=__builtin_amdgcn_mfma_f32_32x32x16_bf16(b1,qr[d0],p1,0,0,0);}}
}
typedef __attribute__((address_space(3))) const char* lds_cptr;
typedef short v4i16_t __attribute__((ext_vector_type(4)));
__device__ __forceinline__ void kload8(bf16x8*kf,lds_cptr kp){
  kf[0]=*(const __attribute__((address_space(3))) bf16x8*)(kp);      kf[1]=*(const __attribute__((address_space(3))) bf16x8*)(kp+512);
  kf[2]=*(const __attribute__((address_space(3))) bf16x8*)(kp+2048); kf[3]=*(const __attribute__((address_space(3))) bf16x8*)(kp+2560);
  kf[4]=*(const __attribute__((address_space(3))) bf16x8*)(kp+4096); kf[5]=*(const __attribute__((address_space(3))) bf16x8*)(kp+4608);
  kf[6]=*(const __attribute__((address_space(3))) bf16x8*)(kp+6144); kf[7]=*(const __attribute__((address_space(3))) bf16x8*)(kp+6656);
}
__device__ __forceinline__ void kload2(bf16x8*kf,lds_cptr kp,int j){ kf[2*j]=*(const __attribute__((address_space(3))) bf16x8*)(kp+j*2048); kf[2*j+1]=*(const __attribute__((address_space(3))) bf16x8*)(kp+j*2048+512); }
__device__ __forceinline__ s16x4 vtr(lds_cptr p){ return __builtin_bit_cast(s16x4,__builtin_amdgcn_ds_read_tr16_b64_v4i16((__attribute__((address_space(3))) v4i16_t*)p)); }
__device__ __forceinline__ float rowmax(const f32x16&p0,const f32x16&p1){
  float a=max3f(p0[0],p0[1],p1[0]),b=max3f(p0[2],p0[3],p1[1]);a=max3f(a,p1[2],p1[3]);
  #pragma unroll
  for(int r=4;r<16;r+=4){a=max3f(a,p0[r],p0[r+1]);b=max3f(b,p0[r+2],p0[r+3]);a=max3f(a,p1[r],p1[r+1]);b=max3f(b,p1[r+2],p1[r+3]);}
  const float m=max2f(a,b);
  auto rr=__builtin_amdgcn_permlane32_swap(__float_as_uint(m),__float_as_uint(m),false,false);
  return max2f(__uint_as_float(rr[0]),__uint_as_float(rr[1]));
}
__device__ __forceinline__ void pv(f32x16*o,int vb,bf16x8 pa0,bf16x8 pa1,bf16x8 pa2,bf16x8 pa3){
  #pragma unroll
  for(int d0=0;d0<2;++d0){s16x4 lo[4],hi[4];
    #pragma unroll
    for(int ks=0;ks<4;++ks){
      asm volatile("ds_read_b64_tr_b16 %0,%1 offset:%c2":"=&v"(lo[ks]):"v"(vb),"i"(d0*4096+ks*1024):"memory");
      asm volatile("ds_read_b64_tr_b16 %0,%1 offset:%c2":"=&v"(hi[ks]):"v"(vb),"i"(d0*4096+ks*1024+512):"memory");}
    asm volatile("s_waitcnt lgkmcnt(0)":::"memory");SBAR();
    #define PK(k) (bf16x8){lo[k][0],lo[k][1],lo[k][2],lo[k][3],hi[k][0],hi[k][1],hi[k][2],hi[k][3]}
    o[d0]=__builtin_amdgcn_mfma_f32_32x32x16_bf16(pa0,PK(0),o[d0],0,0,0);
    o[d0]=__builtin_amdgcn_mfma_f32_32x32x16_bf16(pa1,PK(1),o[d0],0,0,0);
    o[d0]=__builtin_amdgcn_mfma_f32_32x32x16_bf16(pa2,PK(2),o[d0],0,0,0);
    o[d0]=__builtin_amdgcn_mfma_f32_32x32x16_bf16(pa3,PK(3),o[d0],0,0,0);
    #undef PK
  }
}

#ifndef ATTN_STORE16
#define ATTN_STORE16(p,v) (*(u32x4*)(p)=(v))
#endif
template<int THRL> __device__ __forceinline__ void attn_unit(int b,int vh,int qb,const bf16*Q,const bf16*__restrict__ K,const bf16*__restrict__ V,bf16*O,char*shm){
  const int hq=(vh>>2)*128+((vh>>1)&1)*64, hv=(vh>>2)*128+(vh&1)*64, ho=((vh>>1)&1)*1024+(vh>>2)*128+(vh&1)*64;
  int tid_=threadIdx.x; asm volatile("":"+v"(tid_)); const int tid=tid_,lane=tid&63,r32=lane&31,hi=lane>>5; const int wid=__builtin_amdgcn_readfirstlane(tid>>6);
  const long rowbase=(long)b*SEQ; const int q0=qb*QB;
  const bf16*Qw=Q+(rowbase+q0+wid*QBLK)*DM+hq;
  const bf16*Kh=K+rowbase*DM+hq,*Vh=V+rowbase*DM+hv;
  const unsigned lds0=(unsigned)(uintptr_t)shm;
  float*wsf=(float*)(shm+LDS_WS)+wid*64;
  const bf16*ksrc=Kh+(long)lane*DM+wid*8;
  const bf16*vsrc=Vh+(long)(16*(wid&3)+(lane>>2))*DM+(wid>>2)*32+(lane&3)*8;
  const unsigned kdst=lds0+LDS_K+wid*1024, vdst=lds0+LDS_V+wid*1024;
  #define DMA_K(t,slot) glds16(ksrc+(long)(t)*KVBLK*DM,(unsigned)__builtin_amdgcn_readfirstlane(kdst+(slot)))
  #define DMA_V(t,slot) glds16(vsrc+(long)(t)*KVBLK*DM,(unsigned)__builtin_amdgcn_readfirstlane(vdst+(slot)))
  const int vb0=(int)(lds0+LDS_V)+((lane>>4)&1)*32+(lane&3)*8+(4*hi+((lane&15)>>2))*64;
  const char*Kbase=shm+LDS_K; bf16x8 kf[8];
  const lds_cptr shm3=(lds_cptr)shm; const lds_cptr kp0=shm3+LDS_K+hi*1024+r32*16; const lds_cptr vp0=shm3+LDS_V+((lane>>4)&1)*32+(lane&3)*8+(4*hi+((lane&15)>>2))*64;
  const int NT=(q0+QB)/KVBLK;
  DMA_K(0,0);DMA_V(0,0);DMA_K(1,SLOTB);
  bf16x8 qr[4];
  #pragma unroll
  for(int d0=0;d0<4;++d0)qr[d0]=*reinterpret_cast<const bf16x8*>(&Qw[(long)r32*DM+d0*16+hi*8]);
  float mhat=0.f,l_reg=0.f;f32x16 o[2];o[0]=f32x16{};o[1]=f32x16{};f32x16 negm=f32x16{};asm volatile("":"+v"(negm));
  const int qrel=(wid*QBLK+r32)|63;
  #define CMASK(P0,P1,t) do{int jb_=(t)-(NT-4); if(jb_>=0)cmask(P0,P1,jb_,qrel,hi);}while(0)
  bool resc=false;
  #define START(P0,P1) do{ const float rm=rowmax(P0,P1); resc=false; \
    { const float dl=rm; mhat=fadd_s(mhat,dl); \
      _Pragma("unroll") for(int r=0;r<16;++r){P0[r]=fsub_s(P0[r],dl);P1[r]=fsub_s(P1[r],dl);} \
      _Pragma("unroll") for(int r=0;r<16;++r)negm[r]=-mhat; asm volatile("":"+v"(negm)); } \
    _Pragma("unroll") for(int r=0;r<16;++r)P0[r]=__builtin_amdgcn_exp2f(P0[r]); }while(0)
  #define RESC() do{ if(resc){ asm volatile("s_waitcnt lgkmcnt(0)":::"memory"); \
      _Pragma("unroll") for(int d_=0;d_<2;++d_) _Pragma("unroll") for(int r=0;r<16;++r)o[d_][r]*=wsf[crow(r,hi)]; } }while(0)
  f32x16 pA0,pA1,pB0,pB1;
  int sl_prev=0,sl_cur=0,sl_next=SLOTB;
  #define ROT() do{sl_prev=sl_cur;sl_cur=sl_next;sl_next=(sl_next==(NSLOT-1)*SLOTB)?0:sl_next+SLOTB;}while(0)
  DMA_K(2,2*SLOTB);
  WAIT_BAR(3);
  qkt(pA0,pA1,Kbase,qr,negm,r32,hi);asm volatile("s_nop 15\n\ts_nop 7":"+v"(pA0),"+v"(pA1));CMASK(pA0,pA1,0);
  START(pA0,pA1);
  _Pragma("unroll") for(int r=0;r<16;++r)pA1[r]=__builtin_amdgcn_exp2f(pA1[r]);
  WAIT_BAR(0);
  DMA_K(3,0);DMA_V(1,SLOTB);
  ROT();
  kload8(kf,kp0+sl_cur);
  WAIT_BAR(2);
  s16x4 vlo[8],vhi[8]; u32x4 pw0,pw1,pw2,pw3;
  #define PKW(P,B) cvtpk_s(P[B],P[B+1])
  #define PAF(k) __builtin_bit_cast(bf16x8,pw##k)
  #define VFR(i) (bf16x8){vlo[i][0],vlo[i][1],vlo[i][2],vlo[i][3],vhi[i][0],vhi[i][1],vhi[i][2],vhi[i][3]}
  #define PIN(x) asm volatile("":"+v"(x))
  #define MX3(a,b,c) __builtin_fmaxf(__builtin_fmaxf((a),(b)),(c))
  #define GAPA(MF,A0,A1,A2,A3,W0,W1,PW) do{ MF; sacc+=A0; sacc+=A1; sacc+=A2; sacc+=A3; PIN(sacc); W0; W1; PIN(PW); SBAR(); }while(0)
  #define EX(v) __builtin_amdgcn_exp2f(v)
  #define GAPB(MF,X,B) do{ MF; X[B]=EX(X[B]); X[B+1]=EX(X[B+1]); X[B+2]=EX(X[B+2]); X[B+3]=EX(X[B+3]); PIN(X); SBAR(); }while(0)
  #define VRD(i) do{ vlo[i]=vtr(vp_+(((i)>>2)*4096+((i)&3)*1024)); vhi[i]=vtr(vp_+(((i)>>2)*4096+((i)&3)*1024+512)); }while(0)
  #define KRD(G,j) do{ if(G){ kload2(kf,kp0+sl_next,j); SBAR(); } }while(0)
  #define STEP(C0,C1,P0,P1,t,GK,GV,GL) do{ SBAR(); \
    const lds_cptr vp_=vp0+sl_prev; \
    VRD(0); SBAR(); float sacc=(P0[0]+P0[1]); \
    GAPA(C0=__builtin_amdgcn_mfma_f32_32x32x16_bf16(kf[0],qr[0],negm,0,0,0), P0[2],P0[3],P0[4],P0[5],     pw0[0]=PKW(P0,0), pw0[1]=PKW(P0,2), pw0); \
    VRD(4); SBAR(); GAPA(C1=__builtin_amdgcn_mfma_f32_32x32x16_bf16(kf[1],qr[0],negm,0,0,0), P0[6],P0[7],P0[8],P0[9],     pw0[2]=PKW(P0,4), pw0[3]=PKW(P0,6), pw0); \
    VRD(1); SBAR(); GAPA(C0=__builtin_amdgcn_mfma_f32_32x32x16_bf16(kf[2],qr[1],C0,0,0,0),   P0[10],P0[11],P0[12],P0[13], pw1[0]=PKW(P0,8), pw1[1]=PKW(P0,10), pw1); \
    VRD(5); SBAR(); GAPA(C1=__builtin_amdgcn_mfma_f32_32x32x16_bf16(kf[3],qr[1],C1,0,0,0),   P0[14],P0[15],P1[0],P1[1],   pw1[2]=PKW(P0,12),pw1[3]=PKW(P0,14), pw1); \
    VRD(2); SBAR(); GAPA(C0=__builtin_amdgcn_mfma_f32_32x32x16_bf16(kf[4],qr[2],C0,0,0,0),   P1[2],P1[3],P1[4],P1[5],     pw2[0]=PKW(P1,0), pw2[1]=PKW(P1,2), pw2); \
    VRD(6); SBAR(); GAPA(C1=__builtin_amdgcn_mfma_f32_32x32x16_bf16(kf[5],qr[2],C1,0,0,0),   P1[6],P1[7],P1[8],P1[9],     pw2[2]=PKW(P1,4), pw2[3]=PKW(P1,6), pw2); \
    VRD(3); SBAR(); GAPA(C0=__builtin_amdgcn_mfma_f32_32x32x16_bf16(kf[6],qr[3],C0,0,0,0),   P1[10],P1[11],P1[12],P1[13], pw3[0]=PKW(P1,8), pw3[1]=PKW(P1,10), pw3); \
    VRD(7); SBAR(); GAPA(C1=__builtin_amdgcn_mfma_f32_32x32x16_bf16(kf[7],qr[3],C1,0,0,0),   P1[14],P1[15],0.f,0.f,       pw3[2]=PKW(P1,12),pw3[3]=PKW(P1,14), pw3); \
    l_reg+=sacc; \
    if(GK){DMA_K((t)+3,sl_cur);} if(GV){DMA_V((t)+1,sl_next);} \
    CMASK(C0,C1,t); \
    { float a=MX3(C0[0],C0[1],C1[0]),b=MX3(C0[2],C0[3],C1[1]); a=MX3(a,C1[2],C1[3]); \
      _Pragma("unroll") for(int r=4;r<16;r+=4){a=MX3(a,C0[r],C0[r+1]);b=MX3(b,C0[r+2],C0[r+3]);a=MX3(a,C1[r],C1[r+1]);b=MX3(b,C1[r+2],C1[r+3]);} \
      float rm=__builtin_fmaxf(a,b); { auto rr=__builtin_amdgcn_permlane32_swap(__float_as_uint(rm),__float_as_uint(rm),false,false); rm=__builtin_fmaxf(__uint_as_float(rr[0]),__uint_as_float(rr[1])); } \
      resc=false; \
      if(__builtin_expect(__any(rm>(float)THRL),0)){ const float dl=__builtin_fmaxf(rm,0.f); mhat+=dl; \
        _Pragma("unroll") for(int r=0;r<16;++r){C0[r]-=dl;C1[r]-=dl;} \
        _Pragma("unroll") for(int r=0;r<16;++r)negm[r]=-mhat; asm volatile("":"+v"(negm)); \
        const float f=__builtin_amdgcn_exp2f(-dl); l_reg*=f; if(hi==0)wsf[r32]=f; resc=true; } } \
    SBAR(); \
    GAPB(o[0]=__builtin_amdgcn_mfma_f32_32x32x16_bf16(PAF(0),VFR(0),o[0],0,0,0), C0,0); \
    GAPB(o[1]=__builtin_amdgcn_mfma_f32_32x32x16_bf16(PAF(0),VFR(4),o[1],0,0,0), C0,4); \
    KRD(GL,0); GAPB(o[0]=__builtin_amdgcn_mfma_f32_32x32x16_bf16(PAF(1),VFR(1),o[0],0,0,0), C0,8); \
    KRD(GL,1); GAPB(o[1]=__builtin_amdgcn_mfma_f32_32x32x16_bf16(PAF(1),VFR(5),o[1],0,0,0), C0,12); \
    KRD(GL,2); GAPB(o[0]=__builtin_amdgcn_mfma_f32_32x32x16_bf16(PAF(2),VFR(2),o[0],0,0,0), C1,0); \
    KRD(GL,3); GAPB(o[1]=__builtin_amdgcn_mfma_f32_32x32x16_bf16(PAF(2),VFR(6),o[1],0,0,0), C1,4); \
    GAPB(o[0]=__builtin_amdgcn_mfma_f32_32x32x16_bf16(PAF(3),VFR(3),o[0],0,0,0), C1,8); \
    GAPB(o[1]=__builtin_amdgcn_mfma_f32_32x32x16_bf16(PAF(3),VFR(7),o[1],0,0,0), C1,12); \
    }while(0)
  int t=1;
  #undef CMASK
  #define CMASK(P0,P1,t) do{}while(0)
  for(;t+5<NT;t+=2){
    STEP(pB0,pB1,pA0,pA1,t,true,true,true);     WAIT_BAR(2); RESC(); ROT();
    STEP(pA0,pA1,pB0,pB1,t+1,true,true,true);   WAIT_BAR(2); RESC(); ROT();
  }
  #undef CMASK
  #define CMASK(P0,P1,t) do{int jb_=(t)-(NT-4); if(jb_>=0)cmask(P0,P1,jb_,qrel,hi);}while(0)
  #define ENDW(tt) do{ if((tt)+3<NT){WAIT_BAR(2);} else if((tt)+2<NT){WAIT_BAR(1);} else {WAIT_BAR(0);} }while(0)
  for(;t+1<NT;t+=2){
    STEP(pB0,pB1,pA0,pA1,t,(t+3<NT),(t+1<NT),(t+1<NT));       ENDW(t);   RESC(); ROT();
    STEP(pA0,pA1,pB0,pB1,t+1,(t+4<NT),(t+2<NT),(t+2<NT));     ENDW(t+1); RESC(); ROT();
  }
  STEP(pB0,pB1,pA0,pA1,NT-1,false,false,false); RESC();
  { float sacc=pB0[0]+pB0[1]; _Pragma("unroll") for(int r=2;r<16;++r)sacc+=pB0[r]; _Pragma("unroll") for(int r=0;r<16;++r)sacc+=pB1[r]; l_reg+=sacc;
    pw0=(u32x4){PKW(pB0,0),PKW(pB0,2),PKW(pB0,4),PKW(pB0,6)};pw1=(u32x4){PKW(pB0,8),PKW(pB0,10),PKW(pB0,12),PKW(pB0,14)};pw2=(u32x4){PKW(pB1,0),PKW(pB1,2),PKW(pB1,4),PKW(pB1,6)};pw3=(u32x4){PKW(pB1,8),PKW(pB1,10),PKW(pB1,12),PKW(pB1,14)};
    SBAR(); pv(o,vb0+sl_cur,PAF(0),PAF(1),PAF(2),PAF(3)); }
  #undef PKW
  #undef PAF
  #undef VFR
  #undef PIN
  #undef MX3
  #undef GAPA
  #undef GAPB
  #undef EX
  #undef VRD
  #undef KRD
  #undef STEP
  #undef ENDW
  {auto rr=__builtin_amdgcn_permlane32_swap(__float_as_uint(l_reg),__float_as_uint(l_reg),false,false);l_reg=__uint_as_float(rr[0])+__uint_as_float(rr[1]);}
  if(hi==0)wsf[32+r32]=l_reg;asm volatile("s_waitcnt lgkmcnt(0)":::"memory");
  float rli[16];
  #pragma unroll
  for(int r=0;r<16;++r)rli[r]=__builtin_amdgcn_rcpf(wsf[32+crow(r,hi)]);
  bf16*Ow=O+(rowbase+q0+wid*QBLK)*OPITCH+ho;
  { bf16*stg=(bf16*)(shm+LDS_OST)+wid*2048;
    #pragma unroll
    for(int r=0;r<16;++r){const int orow=crow(r,hi);
      #pragma unroll
      for(int d0=0;d0<2;++d0)stg[orow*64+d0*32+r32]=__float2bfloat16(o[d0][r]*rli[r]);}
    asm volatile("s_waitcnt lgkmcnt(0)":::"memory");
    #pragma unroll
    for(int i=0;i<4;++i){const int row=i*8+(lane>>3),ch=lane&7; const u32x4 v=*(const u32x4*)(stg+row*64+ch*8); ATTN_STORE16(Ow+(long)row*OPITCH+ch*8,v);} }
  asm volatile("s_waitcnt lgkmcnt(0)\n\ts_barrier":::"memory");
  #undef DMA_K
  #undef DMA_V
  #undef CMASK
  #undef START
  #undef RESC
  #undef ROT
}
constexpr int ATTN_LDS_BYTES=LDS_BYTES;
struct AttnTensors { const bf16* Q; const bf16* K; const bf16* V; bf16* O; };
struct AttnUnit { int bh; int qb; };
struct StaticOrder {
  int vcu;
  __device__ __forceinline__ explicit StaticOrder(int grid,int block):vcu((block%8)*(grid/8)+block/8){}
  __device__ __forceinline__ bool next(int i,AttnUnit&u)const{ if(i>=8)return false; const int s=vcu&7,ii=i&3; u.bh=(vcu>>3)+32*(i>>2); u.qb=(ii==0)?s:(ii==1)?15-s:(ii==2)?16+s:31-s; return true; }
  __device__ __forceinline__ void a_ready(const AttnUnit&)const{}
  __device__ __forceinline__ void done(const AttnUnit&)const{}
};
template<class Sched,int THRL=8> __device__ __forceinline__ void attn_phase(char*lds,const AttnTensors&T,const Sched&S){
  AttnUnit u;
  for(int i=0;S.next(i,u);++i){ S.a_ready(u); attn_unit<THRL>(u.bh>>5,u.bh&31,u.qb,T.Q,T.K,T.V,T.O,lds); S.done(u); }
}
#undef SBAR
#undef WAIT_BAR
}

#define DI __device__ __forceinline__
#define LAS __attribute__((address_space(3)))
typedef unsigned short bf16_t;
typedef short bf16x8 __attribute__((ext_vector_type(8)));
typedef short s16x4 __attribute__((ext_vector_type(4)));
typedef float f32x4 __attribute__((ext_vector_type(4)));
typedef float f32x16 __attribute__((ext_vector_type(16)));
typedef unsigned u32x4 __attribute__((ext_vector_type(4)));
typedef unsigned u32x2 __attribute__((ext_vector_type(2)));

constexpr int MP = 16384, MS_ = 512, MT = MP + MS_;
constexpr int DMOD = 1024, DFF = 2816, DIN = 9224, NZ = 9216;
constexpr float EPS = 1e-6f;
constexpr float LAM_INIT = 0.2f;
constexpr float QK_C2 = 0.125f * 1.4426950408889634f;
constexpr size_t MiB = 1u << 20;
constexpr size_t WS_W1T = 1 * MiB, WS_W2T = 19 * MiB, WS_W3T = 21 * MiB, WS_W4T = 32 * MiB;
constexpr size_t WS_GATES = 38 * MiB;
constexpr size_t WS_SMALL = 39 * MiB;
constexpr size_t WS_XN = 40 * MiB;
constexpr size_t WS_Z = 73 * MiB, ZSTRIDE = 33 * MiB;
constexpr size_t WS_AO = 370 * MiB;
constexpr size_t WS_HM = 436 * MiB;
constexpr size_t WS_UB = 469 * MiB;
constexpr size_t WS_CS = WS_XN;
constexpr size_t WS_MERGED = WS_Z;
constexpr size_t WS_R = WS_Z + 1 * ZSTRIDE;
constexpr size_t WS_X1 = WS_Z + 3 * ZSTRIDE;
constexpr size_t WS_U3 = WS_Z + 5 * ZSTRIDE;
constexpr size_t WS_G3 = WS_U3 + 91 * MiB;
constexpr size_t WS_ACT = WS_G3 + 91 * MiB;
constexpr size_t WS_END = 512 * MiB;
static_assert((size_t)MT * DFF * 2 <= 91 * MiB && WS_ACT + (size_t)MT * DFF * 2 <= WS_END, "ws map");
static_assert((size_t)MT * 1024 * 2 <= 33 * MiB, "ws map");
constexpr size_t O_Y = 0, O_KP = 17301504, O_VP = 34078720, O_CP = 50855936, O_NP = 51380224, O_MP = 51382272, O_CONVP = 51382280,
                 O_KS = 51393544, O_VS = 51917832, O_CSM = 52442120, O_NS = 56636424, O_MS = 56652808, O_CONVS = 56652872, O_TOTAL = 56742984;
enum { I_XP = 0, I_XS, I_CK, I_CV, I_SC, I_SN, I_SM, I_SCONV, I_GPRE, I_WIN, I_BG, I_LQ1, I_LK1, I_LQ2, I_LK2, I_GAH, I_GMH, I_WOUT, I_GPM, I_GPF, I_WUP, I_CW, I_CB, I_WDN, I_GPFN };
struct KP { const float* in[25]; float* out; unsigned char* ws; };

DI unsigned pk2(float lo, float hi) { typedef float f2 __attribute__((ext_vector_type(2))); typedef __bf16 b2 __attribute__((ext_vector_type(2))); f2 v = {lo, hi}; b2 b = __builtin_convertvector(v, b2); return __builtin_bit_cast(unsigned, b); }
DI float bf_lo(unsigned w) { return __uint_as_float(w << 16); }
DI float bf_hi(unsigned w) { return __uint_as_float(w & 0xffff0000u); }
DI float bf2f(bf16_t v) { return __uint_as_float(((unsigned)v) << 16); }
DI float wave_sum(float v) {
#pragma unroll
  for (int o = 1; o < 64; o <<= 1) v += __shfl_xor(v, o);
  return v; }
DI float wave_max(float v) {
#pragma unroll
  for (int o = 1; o < 64; o <<= 1) v = fmaxf(v, __shfl_xor(v, o));
  return v; }
DI float sigmoidf_(float x) { return 1.0f / (1.0f + __expf(-x)); }
DI float logsig(float x) { return fminf(x, 0.f) - log1pf(expf(-fabsf(x))); }
DI f32x16 mfma32(bf16x8 a, bf16x8 b, f32x16 c) { return __builtin_amdgcn_mfma_f32_32x32x16_bf16(a, b, c, 0, 0, 0); }
DI int crow(int r, int hi) { return (r & 3) + 8 * (r >> 2) + 4 * hi; }
typedef short v4i16_t __attribute__((ext_vector_type(4)));
DI bf16x8 frag_tr(const unsigned char* piece, int lane) {
  const LAS char* p = (const LAS char*)piece + (4 * (lane >> 5) + ((lane & 15) >> 2)) * 64 + ((lane >> 4) & 1) * 32 + (lane & 3) * 8;
  const s16x4 lo = __builtin_bit_cast(s16x4, __builtin_amdgcn_ds_read_tr16_b64_v4i16((LAS v4i16_t*)p));
  const s16x4 hi = __builtin_bit_cast(s16x4, __builtin_amdgcn_ds_read_tr16_b64_v4i16((LAS v4i16_t*)(p + 512)));
  return (bf16x8){lo[0], lo[1], lo[2], lo[3], hi[0], hi[1], hi[2], hi[3]};
}
DI bf16x8 pack8(const f32x16& x, int s) {
  u32x4 p; p.x = pk2(x[8 * s], x[8 * s + 1]); p.y = pk2(x[8 * s + 2], x[8 * s + 3]); p.z = pk2(x[8 * s + 4], x[8 * s + 5]); p.w = pk2(x[8 * s + 6], x[8 * s + 7]);
  return __builtin_bit_cast(bf16x8, p);
}
DI bf16x8 cvt8(f32x4 a, f32x4 b) { u32x4 p; p.x = pk2(a[0], a[1]); p.y = pk2(a[2], a[3]); p.z = pk2(b[0], b[1]); p.w = pk2(b[2], b[3]); return __builtin_bit_cast(bf16x8, p); }

DI float block_scan_add256(float v, int lane, int wid, float* red) {
#pragma unroll
  for (int o = 1; o < 64; o <<= 1) { const float t = __shfl_up(v, o); if (lane >= o) v += t; }
  __syncthreads();
  if (lane == 63 && wid < 4) red[wid] = v;
  __syncthreads();
  float off = 0.f;
#pragma unroll
  for (int w = 0; w < 3; ++w) if (w < wid) off += red[w];
  return v + off;
}
DI float block_scan_max256(float v, int lane, int wid, float* red) {
#pragma unroll
  for (int o = 1; o < 64; o <<= 1) { const float t = __shfl_up(v, o); if (lane >= o) v = fmaxf(v, t); }
  __syncthreads();
  if (lane == 63 && wid < 4) red[wid] = v;
  __syncthreads();
  float off = -3.0e38f;
#pragma unroll
  for (int w = 0; w < 3; ++w) if (w < wid) off = fmaxf(off, red[w]);
  return fmaxf(v, off);
}

template <int MODE> struct EpiX {
  static constexpr bool PERM = true, AFTER_DRAIN = false;
  unsigned char* ws; float* out; float* R;
  DI void operator()(const pg8::f32x4 (&acc)[2][2][4][2], const pg8::Unit& u, int wr, int wc, int fr, int fq) const {
    const int row0 = u.pm * 256 + wr * 64 + fr, cin = wc * 32 + 8 * fq;
    if (MODE == 1) {
      const int seg = u.pn >> 2, colt = (u.pn & 3) * 256;
      bf16_t* zb = (bf16_t*)(ws + WS_Z + (size_t)seg * ZSTRIDE);
      float* fo = nullptr;
      if (seg == 1) fo = (u.pm < 64) ? out + O_KP : out + O_KS - (size_t)MP * 1024;
      if (seg == 2) fo = (u.pm < 64) ? out + O_VP : out + O_VS - (size_t)MP * 1024;
#pragma unroll
      for (int ai = 0; ai < 2; ++ai)
#pragma unroll
        for (int m = 0; m < 4; ++m) { const size_t row = row0 + ai * 128 + m * 16;
#pragma unroll
          for (int bj = 0; bj < 2; ++bj) { const int col = colt + bj * 128 + cin;
            f32x4 v0 = acc[ai][bj][m][0], v1 = acc[ai][bj][m][1];
            if (fo) { *(f32x4*)(fo + row * 1024 + col) = v0; *(f32x4*)(fo + row * 1024 + col + 4) = v1; }
            if (seg == 0) { v0 = v0 * QK_C2; v1 = v1 * QK_C2; }
            else if (seg == 3) { v0 = v0 * 0.0625f; v1 = v1 * 0.0625f; }
            else if (seg >= 6) {
#pragma unroll
              for (int e = 0; e < 4; ++e) { v0[e] = sigmoidf_(v0[e]); v1[e] = sigmoidf_(v1[e]); } }
            u32x4 w; w.x = pk2(v0[0], v0[1]); w.y = pk2(v0[2], v0[3]); w.z = pk2(v1[0], v1[1]); w.w = pk2(v1[2], v1[3]);
            *(u32x4*)(zb + row * 1024 + col) = w; } }
    } else if (MODE == 2) {
#pragma unroll
      for (int ai = 0; ai < 2; ++ai)
#pragma unroll
        for (int m = 0; m < 4; ++m) { const size_t row = row0 + ai * 128 + m * 16;
#pragma unroll
          for (int bj = 0; bj < 2; ++bj) { const int col = u.pn * 256 + bj * 128 + cin;
            *(f32x4*)(R + row * 1024 + col) = acc[ai][bj][m][0]; *(f32x4*)(R + row * 1024 + col + 4) = acc[ai][bj][m][1]; } }
    } else {
      const bool isg = u.pn >= 11; const int colt = (isg ? u.pn - 11 : u.pn) * 256;
      bf16_t* zb = (bf16_t*)(ws + (isg ? WS_G3 : WS_U3));
#pragma unroll
      for (int ai = 0; ai < 2; ++ai)
#pragma unroll
        for (int m = 0; m < 4; ++m) { const size_t row = row0 + ai * 128 + m * 16;
          float* co = nullptr;
          if (isg) { if (row < (size_t)MP) { const int t = (int)row & 8191; if (t >= 8190) co = out + O_CONVP + (size_t)(((int)row >> 13) * 2 + (t - 8190)) * DFF; }
                     else { const int r2 = (int)row - MP, t = r2 & 31; if (t >= 30) co = out + O_CONVS + (size_t)((r2 >> 5) * 2 + (t - 30)) * DFF; } }
#pragma unroll
          for (int bj = 0; bj < 2; ++bj) { const int col = colt + bj * 128 + cin;
            const f32x4 v0 = acc[ai][bj][m][0], v1 = acc[ai][bj][m][1];
            if (co) { *(f32x4*)(co + col) = v0; *(f32x4*)(co + col + 4) = v1; }
            u32x4 w; w.x = pk2(v0[0], v0[1]); w.y = pk2(v0[2], v0[3]); w.z = pk2(v1[0], v1[1]); w.w = pk2(v1[2], v1[3]);
            *(u32x4*)(zb + row * DFF + col) = w; } }
    }
  }
};

DI void transpose_item(const float* W, int K, int ldw, int nblk, int gate_skip, bf16_t* WT, float* scr, int item, int lane) {
  const int kb = item / nblk, nb = item % nblk, k0 = 64 * kb, n0 = 32 * nb, s0 = n0 + ((gate_skip && n0 >= 6144) ? 8 : 0);
#pragma unroll 8
  for (int i = 0; i < 32; ++i) { const int kk = 2 * i + (lane >> 5); scr[kk * 33 + (lane & 31)] = W[(size_t)(k0 + kk) * ldw + s0 + (lane & 31)]; }
  __builtin_amdgcn_s_waitcnt(0); asm volatile("" ::: "memory");
  const int c = lane & 7;
#pragma unroll
  for (int j = 0; j < 4; ++j) { const int n = (lane >> 3) + 8 * j; const float* s = scr + (8 * c) * 33 + n;
    u32x4 o; o.x = pk2(s[0 * 33], s[1 * 33]); o.y = pk2(s[2 * 33], s[3 * 33]); o.z = pk2(s[4 * 33], s[5 * 33]); o.w = pk2(s[6 * 33], s[7 * 33]);
    *(u32x4*)(WT + (size_t)(n0 + n) * K + k0 + 8 * c) = o; }
  __builtin_amdgcn_s_waitcnt(0); asm volatile("" ::: "memory");
}
DI void p0_prologue(const KP& p, unsigned char* lds, int tid, int lane, int wid) {
  float* scr = (float*)(lds + wid * 16384);
  const int gw = blockIdx.x * 8 + wid, NGW = gridDim.x * 8;
  constexpr int I1 = 16 * (NZ / 32), I2 = 16 * 32, I3 = 16 * (2 * DFF / 32), I4 = (DFF / 64) * 32;
  for (int it = gw; it < I1 + I2 + I3 + I4; it += NGW) {
    int r = it;
    if (r < I1) { transpose_item(p.in[I_WIN], 1024, DIN, NZ / 32, 1, (bf16_t*)(p.ws + WS_W1T), scr, r, lane); continue; } r -= I1;
    if (r < I2) { transpose_item(p.in[I_WOUT], 1024, 1024, 32, 0, (bf16_t*)(p.ws + WS_W2T), scr, r, lane); continue; } r -= I2;
    if (r < I3) { transpose_item(p.in[I_WUP], 1024, 2 * DFF, 2 * DFF / 32, 0, (bf16_t*)(p.ws + WS_W3T), scr, r, lane); continue; } r -= I3;
    transpose_item(p.in[I_WDN], DFF, 1024, 32, 0, (bf16_t*)(p.ws + WS_W4T), scr, r, lane);
  }
  __syncthreads();
  float* wg = (float*)lds;
  for (int i = tid; i < 8192; i += 512) wg[i] = p.in[I_WIN][(size_t)(i >> 3) * DIN + 6144 + (i & 7)];
  __syncthreads();
  const float* gpre = p.in[I_GPRE];
  bf16_t* XN = (bf16_t*)(p.ws + WS_XN); float* gates = (float*)(p.ws + WS_GATES);
  for (int row = gw; row < MT; row += NGW) {
    const float* xr = row < MP ? p.in[I_XP] + (size_t)row * 1024 : p.in[I_XS] + (size_t)(row - MP) * 1024;
    f32x4 v[4]; float ss = 0.f;
#pragma unroll
    for (int j = 0; j < 4; ++j) { v[j] = ((const f32x4*)xr)[lane + 64 * j]; ss += (v[j][0] * v[j][0] + v[j][1] * v[j][1]) + (v[j][2] * v[j][2] + v[j][3] * v[j][3]); }
    const float rstd = rsqrtf(wave_sum(ss) * (1.f / 1024.f) + EPS);
    f32x4 ga = {0.f, 0.f, 0.f, 0.f}, gb = {0.f, 0.f, 0.f, 0.f};
#pragma unroll
    for (int j = 0; j < 4; ++j) { const f32x4 gg = ((const f32x4*)gpre)[lane + 64 * j]; v[j] = v[j] * rstd * gg;
      u32x2 o; o.x = pk2(v[j][0], v[j][1]); o.y = pk2(v[j][2], v[j][3]);
      *(u32x2*)(XN + (size_t)row * 1024 + 4 * (lane + 64 * j)) = o;
#pragma unroll
      for (int e = 0; e < 4; ++e) { const f32x4* w = (const f32x4*)(wg + (4 * (lane + 64 * j) + e) * 8); ga += w[0] * v[j][e]; gb += w[1] * v[j][e]; } }
#pragma unroll
    for (int e = 0; e < 4; ++e) { ga[e] = wave_sum(ga[e]); gb[e] = wave_sum(gb[e]); }
    if (lane == 0) { *(f32x4*)(gates + (size_t)row * 8) = ga; *(f32x4*)(gates + (size_t)row * 8 + 4) = gb; }
  }
}

DI float* sm_chF(const KP& p) { return (float*)(p.ws + WS_SMALL); }
DI float* sm_chM(const KP& p) { return (float*)(p.ws + WS_SMALL) + 512; }
DI float* sm_MSt(const KP& p) { return (float*)(p.ws + WS_SMALL) + 1024; }
DI float* sm_nU(const KP& p) { return (float*)(p.ws + WS_SMALL) + 2048; }
DI float* sm_nS(const KP& p) { return (float*)(p.ws + WS_SMALL) + 2048 + 65536; }

DI void mlstm_a_unit(const KP& p, int unit, unsigned char* lds, int tid, int lane, int wid) {
  const int bh = unit >> 5, c = unit & 31, b = bh >> 2, h = bh & 3;
  const int row0 = b * 8192 + c * 256;
  float* sw = (float*)lds;
  float* red = (float*)(lds + 1024);
  unsigned char* img = lds + 2048;
  const float* gates = (const float*)(p.ws + WS_GATES); const float* bg = p.in[I_BG];
  const bf16_t* KM = (const bf16_t*)(p.ws + WS_Z + 4 * ZSTRIDE); const bf16_t* VM = (const bf16_t*)(p.ws + WS_Z + 5 * ZSTRIDE);
  float lf = 0.f, ig = 0.f;
  if (tid < 256) { const float* gr = gates + (size_t)(row0 + tid) * 8; ig = gr[h] + bg[h]; lf = logsig(gr[4 + h] + bg[4 + h]); }
  const float bt = block_scan_add256(lf, lane, wid, red);
  __syncthreads();
  if (tid == 255) red[8] = bt;
  __syncthreads();
  const float F = red[8];
  const float logw = (tid < 256) ? F - bt + ig : -3.0e38f;
  const float wm = wave_max(logw);
  if (lane == 0) red[9 + wid] = wm;
  __syncthreads();
  float mloc = red[9];
#pragma unroll
  for (int w = 1; w < 8; ++w) mloc = fmaxf(mloc, red[9 + w]);
  if (tid < 256) sw[tid] = expf(logw - mloc);
  if (tid == 0) { sm_chF(p)[unit] = F; sm_chM(p)[unit] = mloc; }
  const int wr = wid >> 1, wc = wid & 1, hi = lane >> 5, r32 = lane & 31;
  f32x16 acc[2][4];
#pragma unroll
  for (int a = 0; a < 2; ++a)
#pragma unroll
    for (int q = 0; q < 4; ++q)
#pragma unroll
      for (int i = 0; i < 16; ++i) acc[a][q][i] = 0.f;
  float nacc = 0.f;
#pragma unroll 1
  for (int st = 0; st < 4; ++st) {
    __syncthreads();
#pragma unroll
    for (int i = 0; i < 8; ++i) {
      const int pid = wid * 8 + i, isK = pid >> 5, q = pid & 31, cgp = q >> 2, sg = q & 3;
      const int srow = st * 64 + sg * 16 + (lane >> 2);
      const bf16_t* src = (isK ? KM : VM) + (size_t)(row0 + srow) * 1024 + h * 256 + cgp * 32 + (lane & 3) * 8;
      u32x4 d = *(const u32x4*)src;
      if (!isK) { const float s = sw[srow];
        d.x = pk2(bf_lo(d.x) * s, bf_hi(d.x) * s); d.y = pk2(bf_lo(d.y) * s, bf_hi(d.y) * s); d.z = pk2(bf_lo(d.z) * s, bf_hi(d.z) * s); d.w = pk2(bf_lo(d.w) * s, bf_hi(d.w) * s); }
      *(u32x4*)(img + pid * 1024 + lane * 16) = d;
    }
    __syncthreads();
    if (tid < 256) {
      const int kc = tid;
#pragma unroll 8
      for (int s = 0; s < 64; ++s) nacc += sw[st * 64 + s] * bf2f(*(const bf16_t*)(img + (32 + (kc >> 5) * 4 + (s >> 4)) * 1024 + (s & 15) * 64 + (kc & 31) * 2));
    }
#pragma unroll
    for (int ks = 0; ks < 4; ++ks) {
      bf16x8 af[2], bfr[4];
#pragma unroll
      for (int a = 0; a < 2; ++a) af[a] = frag_tr(img + ((wr * 2 + a) * 4 + ks) * 1024, lane);
#pragma unroll
      for (int q = 0; q < 4; ++q) bfr[q] = frag_tr(img + (32 + (wc * 4 + q) * 4 + ks) * 1024, lane);
#pragma unroll
      for (int a = 0; a < 2; ++a)
#pragma unroll
        for (int q = 0; q < 4; ++q) acc[a][q] = mfma32(af[a], bfr[q], acc[a][q]);
    }
  }
  bf16_t* U = (bf16_t*)(p.ws + WS_UB) + (size_t)unit * 65536 + (wr * 64 + 4 * hi) * 256 + wc * 128 + r32;
  asm volatile("" : "+v"(U));
#pragma unroll
  for (int a = 0; a < 2; ++a)
#pragma unroll
    for (int q = 0; q < 4; ++q)
#pragma unroll
      for (int i = 0; i < 16; ++i) U[(a * 32 + (i & 3) + 8 * (i >> 2)) * 256 + q * 32] = (bf16_t)(pk2(acc[a][q][i], 0.f) & 0xffffu);
  if (tid < 256) sm_nU(p)[unit * 256 + tid] = nacc;
  __syncthreads();
}

DI void mlstm_scan(const KP& p, int tid) {
  const int gt = blockIdx.x * 512 + tid;
  const int bh = gt >> 14, rem = (gt & 16383) * 4;
  const bf16_t* U = (const bf16_t*)(p.ws + WS_UB); bf16_t* CS = (bf16_t*)(p.ws + WS_CS);
  const float* chF = sm_chF(p); const float* chM = sm_chM(p);
  f32x4 C = {0.f, 0.f, 0.f, 0.f}; float M = 0.f, nv = 0.f;
  const bool nthr = (gt & 16383) < 256; const int nk = gt & 255;
#pragma unroll 4
  for (int c = 0; c < 32; ++c) {
    const int un = bh * 32 + c;
    u32x2 o; o.x = pk2(C[0], C[1]); o.y = pk2(C[2], C[3]);
    *(u32x2*)(CS + (size_t)un * 65536 + rem) = o;
    const u32x2 uu = *(const u32x2*)(U + (size_t)un * 65536 + rem);
    const float F = chF[un], ml = chM[un];
    const float Mn = fmaxf(F + M, ml), a = expf(F + M - Mn), bb = expf(ml - Mn);
    if (nthr) { sm_nS(p)[un * 256 + nk] = nv; nv = a * nv + bb * sm_nU(p)[un * 256 + nk]; if (nk == 0) sm_MSt(p)[un] = M; }
    C[0] = a * C[0] + bb * bf_lo(uu.x); C[1] = a * C[1] + bb * bf_hi(uu.x); C[2] = a * C[2] + bb * bf_lo(uu.y); C[3] = a * C[3] + bb * bf_hi(uu.y);
    M = Mn;
  }
  *(f32x4*)(p.out + O_CP + (size_t)bh * 65536 + rem) = C;
  if (nthr) { p.out[O_NP + bh * 256 + nk] = nv; if (nk == 0) p.out[O_MP + bh] = M; }
}

DI void mlstm_c_unit(const KP& p, int unit, unsigned char* lds, int tid, int lane, int wid) {
  const int bh = unit >> 5, c = unit & 31, b = bh >> 2, h = bh & 3;
  const int row0 = b * 8192 + c * 256;
  float* sa = (float*)lds;
  float* smx = (float*)(lds + 1024);
  float* sbt = (float*)(lds + 2048);
  float* sinv = (float*)(lds + 3072);
  float* sn = (float*)(lds + 4096);
  float* red = (float*)(lds + 5120);
  unsigned char* img = lds + 6144;
  const float* gates = (const float*)(p.ws + WS_GATES); const float* bg = p.in[I_BG];
  const bf16_t* QM = (const bf16_t*)(p.ws + WS_Z + 3 * ZSTRIDE); const bf16_t* KM = (const bf16_t*)(p.ws + WS_Z + 4 * ZSTRIDE); const bf16_t* VM = (const bf16_t*)(p.ws + WS_Z + 5 * ZSTRIDE);
  const bf16_t* CS = (const bf16_t*)(p.ws + WS_CS) + (size_t)unit * 65536;
  const float Mc = sm_MSt(p)[unit];
  float lf = 0.f, ig = 0.f;
  if (tid < 256) { const float* gr = gates + (size_t)(row0 + tid) * 8; ig = gr[h] + bg[h]; lf = logsig(gr[4 + h] + bg[4 + h]); sn[tid] = sm_nS(p)[unit * 256 + tid]; }
  const float bt = block_scan_add256(lf, lane, wid, red);
  const float av = (tid < 256) ? ig - bt : -3.0e38f;
  __syncthreads();
  const float pm = block_scan_max256(av, lane, wid, red);
  if (tid < 256) { sa[tid] = av; smx[tid] = fmaxf(Mc, pm); sbt[tid] = bt; }
  __syncthreads();
  const int hi = lane >> 5, r32 = lane & 31, tq = wid * 32 + r32;
  const bf16_t* qrow = QM + (size_t)(row0 + tq) * 1024 + h * 256 + 8 * hi;
  f32x16 acc[8];
#pragma unroll
  for (int v = 0; v < 8; ++v)
#pragma unroll
    for (int i = 0; i < 16; ++i) acc[v][i] = 0.f;
  float nq = 0.f;
#pragma unroll 2
  for (int ks = 0; ks < 16; ++ks) {
    const u32x4 qw = *(const u32x4*)(qrow + ks * 16);
    const bf16x8 qf = __builtin_bit_cast(bf16x8, qw);
    const f32x4 n0 = *(const f32x4*)(sn + ks * 16 + 8 * hi), n1 = *(const f32x4*)(sn + ks * 16 + 8 * hi + 4);
    nq += bf_lo(qw.x) * n0[0] + bf_hi(qw.x) * n0[1] + bf_lo(qw.y) * n0[2] + bf_hi(qw.y) * n0[3] + bf_lo(qw.z) * n1[0] + bf_hi(qw.z) * n1[1] + bf_lo(qw.w) * n1[2] + bf_hi(qw.w) * n1[3];
#pragma unroll
    for (int v = 0; v < 8; ++v) { const bf16x8 cf = *(const bf16x8*)(CS + (size_t)(v * 32 + r32) * 256 + ks * 16 + 8 * hi); acc[v] = mfma32(qf, cf, acc[v]); }
  }
  nq += __shfl_xor(nq, 32);
  {
#pragma unroll
    for (int i = 0; i < 16; ++i) { const float wi = expf(Mc - smx[wid * 32 + crow(i, hi)]);
#pragma unroll
      for (int v = 0; v < 8; ++v) acc[v][i] *= wi; }
  }
  const float mxq = smx[tq];
  float dsum = 0.f;
#pragma unroll 1
  for (int j = 0; j < 8; ++j) {
    unsigned char* buf = img + (j & 1) * 16384;
#pragma unroll
    for (int i = 0; i < 2; ++i) {
      const int pid = wid * 2 + i, cgp = pid >> 1, sg = pid & 1;
      const bf16_t* src = VM + (size_t)(row0 + j * 32 + sg * 16 + (lane >> 2)) * 1024 + h * 256 + cgp * 32 + (lane & 3) * 8;
      *(u32x4*)(buf + pid * 1024 + lane * 16) = *(const u32x4*)src;
    }
    __syncthreads();
    if (j <= wid) {
      f32x16 st;
#pragma unroll
      for (int i = 0; i < 16; ++i) st[i] = 0.f;
      const bf16_t* krow = KM + (size_t)(row0 + j * 32 + r32) * 1024 + h * 256 + 8 * hi;
#pragma unroll 4
      for (int ks = 0; ks < 16; ++ks) { const bf16x8 kf = *(const bf16x8*)(krow + ks * 16); const bf16x8 qf = *(const bf16x8*)(qrow + ks * 16); st = mfma32(kf, qf, st); }
#pragma unroll
      for (int i = 0; i < 16; ++i) { const int s = j * 32 + crow(i, hi);
        const float w = (s <= tq) ? expf(sa[s] - mxq) : 0.f;
        st[i] *= w; dsum += st[i]; }
      const bf16x8 pa0 = pack8(st, 0), pa1 = pack8(st, 1);
#pragma unroll
      for (int v = 0; v < 8; ++v) { acc[v] = mfma32(pa0, frag_tr(buf + (v * 2 + 0) * 1024, lane), acc[v]); acc[v] = mfma32(pa1, frag_tr(buf + (v * 2 + 1) * 1024, lane), acc[v]); }
    }
  }
  dsum += __shfl_xor(dsum, 32);
  {
    const float den = dsum + expf(Mc - mxq) * nq;
    const float dn = fmaxf(fabsf(den), expf(-(sbt[tq] + mxq)));
    if (hi == 0) sinv[tq] = 1.0f / dn;
  }
  __syncthreads();
  bf16_t* HM = (bf16_t*)(p.ws + WS_HM) + (size_t)(row0 + wid * 32 + 4 * hi) * 1024 + h * 256 + r32;
  asm volatile("" : "+v"(HM));
#pragma unroll
  for (int i = 0; i < 16; ++i) { const float inv = sinv[wid * 32 + crow(i, hi)];
#pragma unroll
    for (int v = 0; v < 8; ++v) HM[((i & 3) + 8 * (i >> 2)) * 1024 + v * 32] = (bf16_t)(pk2(acc[v][i] * inv, 0.f) & 0xffffu); }
  __syncthreads();
}

DI void mlstm_sample_unit(const KP& p, int unit, unsigned char* lds, int tid, int lane, int wid) {
  const int vs = unit & 7, h = (unit >> 3) & 3, b = unit >> 5;
  const int row0 = MP + b * 32;
  constexpr int LD = 257;
  float* qs = (float*)lds;
  float* ks = qs + 32 * LD;
  float* Cs = ks + 32 * LD;
  float* vsl = Cs + 32 * LD;
  float* S = vsl + 32 * 33;
  float* sc = S + 32 * 33;
  const bf16_t* QM = (const bf16_t*)(p.ws + WS_Z + 3 * ZSTRIDE); const bf16_t* KM = (const bf16_t*)(p.ws + WS_Z + 4 * ZSTRIDE); const bf16_t* VM = (const bf16_t*)(p.ws + WS_Z + 5 * ZSTRIDE);
  const float* C0 = p.in[I_SC] + ((size_t)(b * 4 + h) * 256 + vs * 32) * 256;
  const float* n0 = p.in[I_SN] + (size_t)(b * 4 + h) * 256;
  const float m0 = p.in[I_SM][b * 4 + h];
  for (int i = tid; i < 32 * 256; i += 512) { const int t = i >> 8, k = i & 255;
    qs[t * LD + k] = bf2f(QM[(size_t)(row0 + t) * 1024 + h * 256 + k]); ks[t * LD + k] = bf2f(KM[(size_t)(row0 + t) * 1024 + h * 256 + k]); Cs[t * LD + k] = C0[t * 256 + k]; }
  for (int i = tid; i < 1024; i += 512) { const int t = i >> 5, v = i & 31; vsl[t * 33 + v] = bf2f(VM[(size_t)(row0 + t) * 1024 + h * 256 + vs * 32 + v]); }
  if (tid == 0) {
    const float* gates = (const float*)(p.ws + WS_GATES); const float* bg = p.in[I_BG];
    float bc = 0.f, pmx = -3.0e38f;
    for (int t = 0; t < 32; ++t) { const float* gr = gates + (size_t)(row0 + t) * 8; const float ig = gr[h] + bg[h]; bc += logsig(gr[4 + h] + bg[4 + h]);
      sc[t] = bc; sc[32 + t] = ig; pmx = fmaxf(pmx, ig - bc); const float mt = bc + fmaxf(m0, pmx); sc[64 + t] = mt; sc[96 + t] = expf(bc + m0 - mt); }
    const float gl = bc; float mn = gl + m0;
    for (int t = 0; t < 32; ++t) mn = fmaxf(mn, gl - sc[t] + sc[32 + t]);
    for (int t = 0; t < 32; ++t) sc[128 + t] = expf(gl - sc[t] + sc[32 + t] - mn);
    sc[192] = expf(gl + m0 - mn); sc[193] = mn;
  }
  __syncthreads();
  for (int i = tid; i < 1024; i += 512) { const int t = i >> 5, s = i & 31; float d = 0.f;
    if (s <= t) {
#pragma unroll 8
      for (int k = 0; k < 256; ++k) d += qs[t * LD + k] * ks[s * LD + k];
      d *= expf(sc[t] - sc[s] + sc[32 + s] - sc[64 + t]); }
    S[t * 33 + s] = d; }
  __syncthreads();
  if (tid < 32) { const int t = tid; float ds = 0.f, nqv = 0.f;
    for (int s = 0; s < 32; ++s) ds += S[t * 33 + s];
    for (int k = 0; k < 256; ++k) nqv += n0[k] * qs[t * LD + k];
    const float den = ds + sc[96 + t] * nqv;
    sc[160 + t] = 1.0f / fmaxf(fabsf(den), expf(-sc[64 + t])); }
  __syncthreads();
  bf16_t* HM = (bf16_t*)(p.ws + WS_HM);
  for (int i = tid; i < 1024; i += 512) { const int t = i >> 5, v = i & 31; float a = 0.f, c2 = 0.f;
#pragma unroll 8
    for (int s = 0; s < 32; ++s) a += S[t * 33 + s] * vsl[s * 33 + v];
#pragma unroll 8
    for (int k = 0; k < 256; ++k) c2 += Cs[v * LD + k] * qs[t * LD + k];
    const float hv = (a + sc[96 + t] * c2) * sc[160 + t];
    HM[(size_t)(row0 + t) * 1024 + h * 256 + vs * 32 + v] = (bf16_t)(pk2(hv, 0.f) & 0xffffu); }
  const float wcf = sc[192];
  { const int k = tid & 255, vh = tid >> 8;
    float* Co = p.out + O_CSM + ((size_t)(b * 4 + h) * 256 + vs * 32) * 256;
    for (int v = vh * 16; v < vh * 16 + 16; ++v) { float a = wcf * Cs[v * LD + k];
#pragma unroll 8
      for (int s = 0; s < 32; ++s) a += sc[128 + s] * vsl[s * 33 + v] * ks[s * LD + k];
      Co[v * 256 + k] = a; }
    if (vs == 0 && tid < 256) { float a = wcf * n0[k];
      for (int s = 0; s < 32; ++s) a += sc[128 + s] * ks[s * LD + k];
      p.out[O_NS + (b * 4 + h) * 256 + k] = a; if (k == 0) p.out[O_MS + b * 4 + h] = sc[193]; } }
  __syncthreads();
}

DI float lam_value(const KP& p, int lane) {
  const float a = wave_sum(p.in[I_LQ1][lane] * p.in[I_LK1][lane]), b = wave_sum(p.in[I_LQ2][lane] * p.in[I_LK2][lane]);
  return expf(a) - expf(b) + LAM_INIT;
}
DI void attn_sample_unit(const KP& p, int unit, unsigned char* lds, int tid, int lane, int wid) {
  const int b = unit >> 3, h = unit & 7, hi = lane >> 5, r32 = lane & 31;
  float* sm = (float*)lds;
  float* sl = sm + 512;
  float* Ored = sl + 512;
  const float lam = lam_value(p, lane);
  for (int i = tid; i < 4096; i += 512) Ored[i] = 0.f;
  const bf16_t* QA = (const bf16_t*)(p.ws + WS_Z);
  bf16x8 qf[2][4];
#pragma unroll
  for (int m = 0; m < 2; ++m)
#pragma unroll
    for (int d0 = 0; d0 < 4; ++d0) qf[m][d0] = *(const bf16x8*)(QA + (size_t)(MP + b * 32 + r32) * 1024 + h * 128 + m * 64 + d0 * 16 + 8 * hi);
  const float* ck = p.in[I_CK] + ((size_t)b * 2048 * 8 + h) * 128; const float* cv = p.in[I_CV] + ((size_t)b * 2048 * 8 + h) * 128;
  const float* nk = p.out + O_KS + ((size_t)b * 32 * 8 + h) * 128; const float* nv = p.out + O_VS + ((size_t)b * 32 * 8 + h) * 128;
  float mr[2] = {-1.0e30f, -1.0e30f}, lr[2] = {0.f, 0.f};
#pragma unroll 1
  for (int j = wid; j < 65; j += 8) {
    const float* kb = (j < 64 ? ck + (size_t)j * 32 * 1024 : nk) + (size_t)r32 * 1024 + 8 * hi;
#pragma unroll
    for (int m = 0; m < 2; ++m) {
      f32x16 s;
#pragma unroll
      for (int i = 0; i < 16; ++i) s[i] = 0.f;
#pragma unroll
      for (int d0 = 0; d0 < 4; ++d0) { const f32x4 x0 = *(const f32x4*)(kb + m * 64 + d0 * 16), x1 = *(const f32x4*)(kb + m * 64 + d0 * 16 + 4); s = mfma32(cvt8(x0, x1), qf[m][d0], s); }
      float mx = s[0];
#pragma unroll
      for (int i = 1; i < 16; ++i) mx = fmaxf(mx, s[i]);
      mx = fmaxf(mx, __shfl_xor(mx, 32));
      const float mn = fmaxf(mr[m], mx); float ls = 0.f;
#pragma unroll
      for (int i = 0; i < 16; ++i) ls += exp2f(s[i] - mn);
      lr[m] = lr[m] * exp2f(mr[m] - mn) + ls; mr[m] = mn;
    }
  }
#pragma unroll
  for (int m = 0; m < 2; ++m) { lr[m] += __shfl_xor(lr[m], 32); if (hi == 0) { sm[(m * 8 + wid) * 32 + r32] = mr[m]; sl[(m * 8 + wid) * 32 + r32] = lr[m]; } }
  __syncthreads();
  float Mx[2], Li[2];
#pragma unroll
  for (int m = 0; m < 2; ++m) { float mm = -1.0e30f;
#pragma unroll
    for (int w = 0; w < 8; ++w) mm = fmaxf(mm, sm[(m * 8 + w) * 32 + r32]);
    float ll = 0.f;
#pragma unroll
    for (int w = 0; w < 8; ++w) ll += sl[(m * 8 + w) * 32 + r32] * exp2f(sm[(m * 8 + w) * 32 + r32] - mm);
    Mx[m] = mm; Li[m] = 1.0f / ll; }
  f32x16 o[4];
#pragma unroll
  for (int d = 0; d < 4; ++d)
#pragma unroll
    for (int i = 0; i < 16; ++i) o[d][i] = 0.f;
#pragma unroll 1
  for (int j = wid; j < 65; j += 8) {
    const float* kb = (j < 64 ? ck + (size_t)j * 32 * 1024 : nk) + (size_t)r32 * 1024 + 8 * hi;
    const float* vb = (j < 64 ? cv + (size_t)j * 32 * 1024 : nv) + r32;
    f32x16 s[2];
#pragma unroll
    for (int m = 0; m < 2; ++m) {
#pragma unroll
      for (int i = 0; i < 16; ++i) s[m][i] = 0.f;
#pragma unroll
      for (int d0 = 0; d0 < 4; ++d0) { const f32x4 x0 = *(const f32x4*)(kb + m * 64 + d0 * 16), x1 = *(const f32x4*)(kb + m * 64 + d0 * 16 + 4); s[m] = mfma32(cvt8(x0, x1), qf[m][d0], s[m]); }
    }
    f32x16 a;
#pragma unroll
    for (int i = 0; i < 16; ++i) a[i] = exp2f(s[0][i] - Mx[0]) * Li[0] - lam * (exp2f(s[1][i] - Mx[1]) * Li[1]);
#pragma unroll
    for (int s2 = 0; s2 < 2; ++s2) {
      const bf16x8 pa = pack8(a, s2);
#pragma unroll
      for (int d = 0; d < 4; ++d) {
        float x[8];
#pragma unroll
        for (int jj = 0; jj < 8; ++jj) x[jj] = vb[(size_t)(16 * s2 + 8 * (jj >> 2) + 4 * hi + (jj & 3)) * 1024 + d * 32];
        const bf16x8 vf = cvt8((f32x4){x[0], x[1], x[2], x[3]}, (f32x4){x[4], x[5], x[6], x[7]});
        o[d] = mfma32(pa, vf, o[d]);
      }
    }
  }
#pragma unroll
  for (int d = 0; d < 4; ++d)
#pragma unroll
    for (int i = 0; i < 16; ++i) atomicAdd(&Ored[crow(i, hi) * 128 + d * 32 + r32], o[d][i]);
  __syncthreads();
  { const int q = tid >> 4, d8 = (tid & 15) * 8; const float* s = Ored + q * 128 + d8;
    u32x4 w; w.x = pk2(s[0], s[1]); w.y = pk2(s[2], s[3]); w.z = pk2(s[4], s[5]); w.w = pk2(s[6], s[7]);
    bf16_t* AO = (bf16_t*)(p.ws + WS_AO) + (size_t)(MP + b * 32 + q) * 2048 + h * 128 + d8;
    *(u32x4*)AO = w; *(u32x4*)(AO + 1024) = (u32x4){0u, 0u, 0u, 0u}; }
  __syncthreads();
}

DI void merge_rows(const KP& p, int lane, int wid) {
  const float lam = lam_value(p, lane);
  const bf16_t* AO = (const bf16_t*)(p.ws + WS_AO); const bf16_t* HM = (const bf16_t*)(p.ws + WS_HM);
  const bf16_t* OM = (const bf16_t*)(p.ws + WS_Z + 6 * ZSTRIDE); const bf16_t* GA = (const bf16_t*)(p.ws + WS_Z + 7 * ZSTRIDE); const bf16_t* GM = (const bf16_t*)(p.ws + WS_Z + 8 * ZSTRIDE);
  bf16_t* MG = (bf16_t*)(p.ws + WS_MERGED);
  const int c0 = lane * 16;
  float gah[16], gmh[16];
#pragma unroll
  for (int e = 0; e < 16; ++e) { gah[e] = p.in[I_GAH][(c0 + e) & 127] * (1.0f - LAM_INIT); gmh[e] = p.in[I_GMH][c0 + e]; }
  for (int row = blockIdx.x * 8 + wid; row < MT; row += gridDim.x * 8) {
    float a[16], hm[16], om[16], ga[16], gm[16];
#define LD16(dst, ptr) do { const u32x4 w0_ = *(const u32x4*)(ptr), w1_ = *(const u32x4*)((ptr) + 8); \
      dst[0] = bf_lo(w0_.x); dst[1] = bf_hi(w0_.x); dst[2] = bf_lo(w0_.y); dst[3] = bf_hi(w0_.y); dst[4] = bf_lo(w0_.z); dst[5] = bf_hi(w0_.z); dst[6] = bf_lo(w0_.w); dst[7] = bf_hi(w0_.w); \
      dst[8] = bf_lo(w1_.x); dst[9] = bf_hi(w1_.x); dst[10] = bf_lo(w1_.y); dst[11] = bf_hi(w1_.y); dst[12] = bf_lo(w1_.z); dst[13] = bf_hi(w1_.z); dst[14] = bf_lo(w1_.w); dst[15] = bf_hi(w1_.w); } while (0)
    { float o2[16]; LD16(a, AO + (size_t)row * 2048 + c0); LD16(o2, AO + (size_t)row * 2048 + 1024 + c0);
#pragma unroll
      for (int e = 0; e < 16; ++e) a[e] -= lam * o2[e]; }
    LD16(hm, HM + (size_t)row * 1024 + c0); LD16(om, OM + (size_t)row * 1024 + c0); LD16(ga, GA + (size_t)row * 1024 + c0); LD16(gm, GM + (size_t)row * 1024 + c0);
    float sa = 0.f, sh = 0.f;
#pragma unroll
    for (int e = 0; e < 16; ++e) { sa += a[e] * a[e]; sh += hm[e] * hm[e]; }
    sa += __shfl_xor(sa, 1); sa += __shfl_xor(sa, 2); sa += __shfl_xor(sa, 4);
    sh += __shfl_xor(sh, 1); sh += __shfl_xor(sh, 2); sh += __shfl_xor(sh, 4); sh += __shfl_xor(sh, 8);
    const float ra = rsqrtf(sa * (1.f / 128.f) + EPS), rh = rsqrtf(sh * (1.f / 256.f) + EPS);
    float o[16];
#pragma unroll
    for (int e = 0; e < 16; ++e) o[e] = ga[e] * (a[e] * ra * gah[e]) + gm[e] * (om[e] * (hm[e] * rh * gmh[e]));
    u32x4 w0, w1; w0.x = pk2(o[0], o[1]); w0.y = pk2(o[2], o[3]); w0.z = pk2(o[4], o[5]); w0.w = pk2(o[6], o[7]); w1.x = pk2(o[8], o[9]); w1.y = pk2(o[10], o[11]); w1.z = pk2(o[12], o[13]); w1.w = pk2(o[14], o[15]);
    *(u32x4*)(MG + (size_t)row * 1024 + c0) = w0; *(u32x4*)(MG + (size_t)row * 1024 + c0 + 8) = w1;
  }
}
DI void norm_rows(const KP& p, int lane, int wid) {
  const float* R = (const float*)(p.ws + WS_R); float* X1 = (float*)(p.ws + WS_X1); bf16_t* XN = (bf16_t*)(p.ws + WS_XN);
  for (int row = blockIdx.x * 8 + wid; row < MT; row += gridDim.x * 8) {
    const float* xr = row < MP ? p.in[I_XP] + (size_t)row * 1024 : p.in[I_XS] + (size_t)(row - MP) * 1024;
    f32x4 r[4], x[4]; float ss = 0.f;
#pragma unroll
    for (int j = 0; j < 4; ++j) { r[j] = ((const f32x4*)(R + (size_t)row * 1024))[lane + 64 * j]; x[j] = ((const f32x4*)xr)[lane + 64 * j]; ss += (r[j][0] * r[j][0] + r[j][1] * r[j][1]) + (r[j][2] * r[j][2] + r[j][3] * r[j][3]); }
    const float rs = rsqrtf(wave_sum(ss) * (1.f / 1024.f) + EPS); float s2 = 0.f;
#pragma unroll
    for (int j = 0; j < 4; ++j) { x[j] = x[j] + r[j] * rs * ((const f32x4*)p.in[I_GPM])[lane + 64 * j]; ((f32x4*)(X1 + (size_t)row * 1024))[lane + 64 * j] = x[j];
      s2 += (x[j][0] * x[j][0] + x[j][1] * x[j][1]) + (x[j][2] * x[j][2] + x[j][3] * x[j][3]); }
    const float r2 = rsqrtf(wave_sum(s2) * (1.f / 1024.f) + EPS);
#pragma unroll
    for (int j = 0; j < 4; ++j) { const f32x4 v = x[j] * r2 * ((const f32x4*)p.in[I_GPF])[lane + 64 * j]; u32x2 o; o.x = pk2(v[0], v[1]); o.y = pk2(v[2], v[3]);
      *(u32x2*)(XN + (size_t)row * 1024 + 4 * (lane + 64 * j)) = o; }
  }
}
DI void final_rows(const KP& p, int lane, int wid) {
  const float* R = (const float*)(p.ws + WS_R); const float* X1 = (const float*)(p.ws + WS_X1);
  for (int row = blockIdx.x * 8 + wid; row < MT; row += gridDim.x * 8) {
    f32x4 r[4]; float ss = 0.f;
#pragma unroll
    for (int j = 0; j < 4; ++j) { r[j] = ((const f32x4*)(R + (size_t)row * 1024))[lane + 64 * j]; ss += (r[j][0] * r[j][0] + r[j][1] * r[j][1]) + (r[j][2] * r[j][2] + r[j][3] * r[j][3]); }
    const float rs = rsqrtf(wave_sum(ss) * (1.f / 1024.f) + EPS);
#pragma unroll
    for (int j = 0; j < 4; ++j) ((f32x4*)(p.out + O_Y + (size_t)row * 1024))[lane + 64 * j] = ((const f32x4*)(X1 + (size_t)row * 1024))[lane + 64 * j] + r[j] * rs * ((const f32x4*)p.in[I_GPFN])[lane + 64 * j];
  }
}
DI float gelu_tanh(float x) { const float z = 0.7978845608028654f * (x + 0.044715f * x * x * x); const float t = 1.0f - 2.0f / (__expf(2.0f * z) + 1.0f); return 0.5f * x * (1.0f + t); }
DI void act_phase(const KP& p, int tid) {
  const bf16_t* U3 = (const bf16_t*)(p.ws + WS_U3); const bf16_t* G3 = (const bf16_t*)(p.ws + WS_G3); bf16_t* ACT = (bf16_t*)(p.ws + WS_ACT);
  const float* cw = p.in[I_CW]; const float* cb = p.in[I_CB]; const float* sconv = p.in[I_SCONV];
  constexpr int CPR = DFF / 8;
  for (size_t it = (size_t)blockIdx.x * 512 + tid; it < (size_t)MT * CPR; it += (size_t)gridDim.x * 512) {
    const int row = (int)(it / CPR), c0 = (int)(it % CPR) * 8;
    int t, bs = -1; if (row < MP) t = row & 8191; else { t = (row - MP) & 31; bs = (row - MP) >> 5; }
    float g[3][8];
#pragma unroll
    for (int j = 0; j < 3; ++j) {
      const int tt = t + j - 2;
      if (tt >= 0) { const u32x4 w = *(const u32x4*)(G3 + (size_t)(row + j - 2) * DFF + c0);
        g[j][0] = bf_lo(w.x); g[j][1] = bf_hi(w.x); g[j][2] = bf_lo(w.y); g[j][3] = bf_hi(w.y); g[j][4] = bf_lo(w.z); g[j][5] = bf_hi(w.z); g[j][6] = bf_lo(w.w); g[j][7] = bf_hi(w.w); }
      else if (bs >= 0) { const float* s = sconv + (size_t)(bs * 2 + (tt + 2)) * DFF + c0;
#pragma unroll
        for (int e = 0; e < 8; ++e) g[j][e] = s[e]; }
      else {
#pragma unroll
        for (int e = 0; e < 8; ++e) g[j][e] = 0.f; }
    }
    const u32x4 uw = *(const u32x4*)(U3 + (size_t)row * DFF + c0);
    float u[8] = {bf_lo(uw.x), bf_hi(uw.x), bf_lo(uw.y), bf_hi(uw.y), bf_lo(uw.z), bf_hi(uw.z), bf_lo(uw.w), bf_hi(uw.w)};
    float o[8];
#pragma unroll
    for (int e = 0; e < 8; ++e) { const float gc = cb[c0 + e] + cw[c0 + e] * g[0][e] + cw[DFF + c0 + e] * g[1][e] + cw[2 * DFF + c0 + e] * g[2][e]; o[e] = gelu_tanh(gc) * u[e]; }
    u32x4 w; w.x = pk2(o[0], o[1]); w.y = pk2(o[2], o[3]); w.z = pk2(o[4], o[5]); w.w = pk2(o[6], o[7]);
    *(u32x4*)(ACT + (size_t)row * DFF + c0) = w;
  }
}

constexpr int LDS_BYTES = 147456;
__global__ void __launch_bounds__(512, 2) fwd_megakernel(KP p) {
  extern __shared__ __attribute__((aligned(16))) unsigned char lds[];
  cg::grid_group grid = cg::this_grid();
  int tid = threadIdx.x, lane = tid & 63, wid = __builtin_amdgcn_readfirstlane(tid >> 6);
  const int G = gridDim.x, bx = blockIdx.x;
#define RELAUNDER() do { tid = threadIdx.x; asm volatile("" : "+v"(tid)); lane = tid & 63; wid = __builtin_amdgcn_readfirstlane(tid >> 6); } while (0)
#ifndef SK_P0
  p0_prologue(p, lds, tid, lane, wid);
#endif
  grid.sync(); RELAUNDER();
  { pg8::Gemm g{(const bf16_t*)(p.ws + WS_XN), (const bf16_t*)(p.ws + WS_W1T), MT, NZ, 1024}; pg8::StaticOrder S; S.init(MT, NZ, G, bx);
    EpiX<1> E{p.ws, p.out, nullptr};
    pg8::gemm_phase<EpiX<1>, pg8::StaticOrder, true, true>((LAS unsigned char*)lds, g, S, E); }
  grid.sync(); RELAUNDER();
#ifndef SK_MA
  for (int u = bx; u < 256; u += G) mlstm_a_unit(p, u, lds, tid, lane, wid);
#endif
  for (int u = bx; u < 128 + 512; u += G) {
#ifndef SK_AS
    if (u < 128) attn_sample_unit(p, u, lds, tid, lane, wid);
#endif
#ifndef SK_MS
    if (u >= 128) mlstm_sample_unit(p, u - 128, lds, tid, lane, wid);
#endif
  }
  grid.sync(); RELAUNDER();
#ifndef SK_SC
  if (bx < 256) mlstm_scan(p, tid);
#endif
  grid.sync(); RELAUNDER();
#ifndef SK_MC
  for (int u = bx; u < 256; u += G) mlstm_c_unit(p, u, lds, tid, lane, wid);
#endif
  { const attn_body::AttnTensors AT{(const attn_body::bf16*)(p.ws + WS_Z), (const attn_body::bf16*)(p.ws + WS_Z + ZSTRIDE), (const attn_body::bf16*)(p.ws + WS_Z + 2 * ZSTRIDE), (attn_body::bf16*)(p.ws + WS_AO)};
    const attn_body::StaticOrder S(G, bx);
    attn_body::attn_phase<attn_body::StaticOrder>((char*)lds, AT, S); }
  grid.sync(); RELAUNDER();
#ifndef SK_MG
  merge_rows(p, lane, wid);
#endif
  grid.sync(); RELAUNDER();
  { pg8::Gemm g{(const bf16_t*)(p.ws + WS_MERGED), (const bf16_t*)(p.ws + WS_W2T), MT, 1024, 1024}; pg8::StaticOrder S; S.init(MT, 1024, G, bx);
    EpiX<2> E{p.ws, p.out, (float*)(p.ws + WS_R)};
    pg8::gemm_phase<EpiX<2>, pg8::StaticOrder, true, true>((LAS unsigned char*)lds, g, S, E); }
  grid.sync(); RELAUNDER();
  norm_rows(p, lane, wid);
  grid.sync(); RELAUNDER();
  { pg8::Gemm g{(const bf16_t*)(p.ws + WS_XN), (const bf16_t*)(p.ws + WS_W3T), MT, 2 * DFF, 1024}; pg8::StaticOrder S; S.init(MT, 2 * DFF, G, bx);
    EpiX<3> E{p.ws, p.out, nullptr};
    pg8::gemm_phase<EpiX<3>, pg8::StaticOrder, true, true>((LAS unsigned char*)lds, g, S, E); }
  grid.sync(); RELAUNDER();
#ifndef SK_ACT
  act_phase(p, tid);
#endif
  grid.sync(); RELAUNDER();
  { pg8::Gemm g{(const bf16_t*)(p.ws + WS_ACT), (const bf16_t*)(p.ws + WS_W4T), MT, 1024, DFF}; pg8::StaticOrder S; S.init(MT, 1024, G, bx);
    EpiX<2> E{p.ws, p.out, (float*)(p.ws + WS_R)};
    pg8::gemm_phase<EpiX<2>, pg8::StaticOrder, true, true>((LAS unsigned char*)lds, g, S, E); }
  grid.sync(); RELAUNDER();
  final_rows(p, lane, wid);
}

extern "C" void kernel_launch(void* const* d_in, const int* in_sizes, int n_in, void* d_out, int out_size, void* d_ws, size_t ws_size, hipStream_t stream) {
  static int grid = 0;
  if (grid == 0) {
    if (n_in != 25 || (size_t)out_size != O_TOTAL || ws_size < WS_END) { fprintf(stderr, "kernel_launch: unexpected shapes: n_in %d out %d ws %zu\n", n_in, out_size, ws_size); grid = -1; return; }
    int dev = 0, cus = 0, per_cu = 0;
    (void)hipGetDevice(&dev); (void)hipDeviceGetAttribute(&cus, hipDeviceAttributeMultiprocessorCount, dev);
    if (hipFuncSetAttribute((const void*)fwd_megakernel, hipFuncAttributeMaxDynamicSharedMemorySize, LDS_BYTES) != hipSuccess) { fprintf(stderr, "kernel_launch: hipFuncSetAttribute failed\n"); grid = -1; return; }
    if (hipOccupancyMaxActiveBlocksPerMultiprocessor(&per_cu, (const void*)fwd_megakernel, 512, LDS_BYTES) != hipSuccess || per_cu < 1) { fprintf(stderr, "kernel_launch: occupancy query says %d\n", per_cu); per_cu = 1; }
    (void)hipGetLastError();
    grid = cus;
    if (grid > 256) grid = 256;
  }
  if (grid < 0) return;
  KP p{};
  for (int i = 0; i < 25; ++i) p.in[i] = (const float*)d_in[i];
  p.out = (float*)d_out; p.ws = (unsigned char*)d_ws;
  void* args[] = {&p};
  hipError_t e = hipLaunchCooperativeKernel((const void*)fwd_megakernel, dim3(grid), dim3(512), args, LDS_BYTES, stream);
  if (e != hipSuccess) fprintf(stderr, "cooperative launch failed: %s (grid %d)\n", hipGetErrorString(e), grid);
}
```

```cpp
#include <hip/hip_runtime.h>
#include <hip/hip_cooperative_groups.h>
#include <hip/hip_bf16.h>
#include <cstdio>
#include <cstdint>
#include <cmath>
namespace cg = cooperative_groups;
namespace pg8 {
#define PG8_LAS __attribute__((address_space(3)))
typedef unsigned short bf16_t;
typedef short bf16x8 __attribute__((ext_vector_type(8)));
typedef float f32x4 __attribute__((ext_vector_type(4)));
typedef unsigned u32x4 __attribute__((ext_vector_type(4)));
constexpr int BM = 256, BK = 64, HALF = 128, HTB = HALF * BK * 2  , STAGE_BYTES = 8 * HTB, NXCD = 8, WGM = 8;

__host__ __device__ __forceinline__ int lds_byte(int r, int c) { const int st = (r >> 4) * 2 + (c >> 5), rr = r & 15, cc = c & 31, ob = rr * 64 + cc * 2; return st * 1024 + (ob ^ (((ob >> 9) & 1) << 5)); }
__host__ __device__ __forceinline__ void stage_rc(int b, int& R, int& C) { const int st = b / 1024, sb = b % 1024, swz = sb ^ (((sb >> 9) & 1) << 5); R = (st >> 1) * 16 + swz / 64; C = (st & 1) * 32 + (swz % 64) / 2; }
__host__ __device__ __forceinline__ int perm32(int rho) { const int n = rho >> 4, i = rho & 15; return 8 * (i >> 2) + 4 * n + (i & 3); }

struct Unit { int pm, pn; };
struct Gemm { const bf16_t* A; const bf16_t* Bt; int M, N, K; };

struct StaticOrder {
    int nM, nN, nwg, G, c;
    __host__ __device__ void init(int M, int N, int G_, int c_) { nM = M / BM; nN = N / BM; nwg = nM * nN; G = G_; c = c_; }
    __host__ __device__ bool next(int i, Unit& u) const {
        const long L = (long)i * G + c; if (L >= nwg) return false;
        int wgid = (int)L; { const int q = nwg / NXCD, r = nwg % NXCD, xcd = wgid % NXCD, off = wgid / NXCD; wgid = (xcd < r ? xcd * (q + 1) : r * (q + 1) + (xcd - r) * q) + off; }
        const int nig = WGM * nN, gid = wgid / nig, fm = gid * WGM, gsz = (nM - fm) < WGM ? (nM - fm) : WGM;
        u.pm = fm + ((wgid % nig) % gsz); u.pn = (wgid % nig) / gsz; return true;
    }
    __device__ __forceinline__ void a_ready(const Unit&) const {}
    __device__ __forceinline__ void done(const Unit&) const {}
};

__device__ __forceinline__ unsigned cvt_pk_bf16(float lo, float hi) { unsigned r; asm volatile("v_cvt_pk_bf16_f32 %0, %1, %2" : "=v"(r) : "v"(lo), "v"(hi)); return r; }
typedef float f32x2 __attribute__((ext_vector_type(2)));
__device__ __forceinline__ f32x2 gelu_pk(f32x2 v) {
    const f32x2 av = __builtin_elementwise_abs(v), d = av * 0.2316418882f + 1.0f;
    f32x2 t; t.x = __builtin_amdgcn_rcpf(d.x); t.y = __builtin_amdgcn_rcpf(d.y);
    f32x2 q = t * 0.5307027145f + (-0.7265760135f); q = q * t + 0.7107068705f; q = q * t + (-0.142248368f); q = q * t + 0.127414796f; q = q * t;
    const f32x2 s = (v * v) * (-0.72134752044f);
    f32x2 e; e.x = __builtin_amdgcn_exp2f(s.x); e.y = __builtin_amdgcn_exp2f(s.y);
    const f32x2 m = v * (q * e), r = v - m;
    f32x2 o; o.x = v.x < 0.f ? m.x : r.x; o.y = v.y < 0.f ? m.y : r.y; return o;
}

template <int ACT  > struct EpiBf16 {
    static constexpr bool PERM = true, AFTER_DRAIN = false; static_assert(ACT == 0 || ACT == 1, "EpiBf16: ACT is 0 (none) or 1 (gelu_pk)");
    bf16_t* O; int ldc; const float* bias; int split_cols; size_t split_stride; float scale0;
    __device__ __forceinline__ void operator()(const f32x4 (&acc)[2][2][4][2], const Unit& u, int wr, int wc, int fr, int fq) const {
        const int row0 = u.pm * BM + wr * 64 + fr; int colt = u.pn * BM; bf16_t* base = O;
        float sc = 1.f; if (split_cols) { const int t = colt / split_cols; base += (size_t)t * split_stride; colt -= t * split_cols; if (t == 0) sc = scale0; }
        const int col0 = colt + wc * 32 + 8 * fq, bcol0 = u.pn * BM + wc * 32 + 8 * fq;
        f32x4 bv[2][2];
#pragma unroll
        for (int bj = 0; bj < 2; ++bj)
#pragma unroll
            for (int n = 0; n < 2; ++n) bv[bj][n] = bias ? *(const f32x4*)(bias + bcol0 + bj * HALF + 4 * n) : (f32x4){0.f, 0.f, 0.f, 0.f};
#pragma unroll
        for (int ai = 0; ai < 2; ++ai)
#pragma unroll
            for (int m = 0; m < 4; ++m) { bf16_t* rowp = base + (size_t)(row0 + ai * HALF + m * 16) * ldc + col0;
#pragma unroll
                for (int bj = 0; bj < 2; ++bj) { f32x4 v0 = acc[ai][bj][m][0] + bv[bj][0], v1 = acc[ai][bj][m][1] + bv[bj][1];
                    if (ACT == 1) { f32x2 a = gelu_pk((f32x2){v0[0], v0[1]}), b = gelu_pk((f32x2){v0[2], v0[3]}), c = gelu_pk((f32x2){v1[0], v1[1]}), d = gelu_pk((f32x2){v1[2], v1[3]});
                        v0 = (f32x4){a.x, a.y, b.x, b.y}; v1 = (f32x4){c.x, c.y, d.x, d.y}; }
                    v0 = v0 * sc; v1 = v1 * sc; u32x4 w; w.x = cvt_pk_bf16(v0[0], v0[1]); w.y = cvt_pk_bf16(v0[2], v0[3]); w.z = cvt_pk_bf16(v1[0], v1[1]); w.w = cvt_pk_bf16(v1[2], v1[3]);
                    *(u32x4*)(rowp + bj * HALF) = w; } }
    }
};

struct PanelStats {
    unsigned* xbuf;
    unsigned* cnt;
    unsigned* tmo;
    int ntn; float eps;
    unsigned code;
    __device__ __forceinline__ bool run(const f32x4 (&v)[2][2][4][2], const Unit& u, int wr, int wc, int fr, int fq, PG8_LAS unsigned char* lds, int wid, int lane) const {
        typedef float f32x2v __attribute__((ext_vector_type(2)));
        PG8_LAS f32x2v* P = (PG8_LAS f32x2v*)lds;
        PG8_LAS f32x2v* S = (PG8_LAS f32x2v*)(lds + 8192);
        PG8_LAS unsigned* flag = (PG8_LAS unsigned*)(lds + 8192 + 2048);
#pragma unroll
        for (int ai = 0; ai < 2; ++ai)
#pragma unroll
            for (int m = 0; m < 4; ++m) {
                float s = 0.f;
#pragma unroll
                for (int bj = 0; bj < 2; ++bj)
#pragma unroll
                    for (int n = 0; n < 2; ++n) { const f32x4 x = v[ai][bj][m][n]; s += (x[0] + x[1]) + (x[2] + x[3]); }
                s += __shfl_xor(s, 16); s += __shfl_xor(s, 32);
                const float mw = s * (1.0f / 64.0f); float q = 0.f;
#pragma unroll
                for (int bj = 0; bj < 2; ++bj)
#pragma unroll
                    for (int n = 0; n < 2; ++n) { const f32x4 d = v[ai][bj][m][n] - mw; q += (d[0] * d[0] + d[1] * d[1]) + (d[2] * d[2] + d[3] * d[3]); }
                q += __shfl_xor(q, 16); q += __shfl_xor(q, 32);
                if (fq == 0) P[(ai * HALF + wr * 64 + m * 16 + fr) * 4 + wc] = (f32x2v){mw, q};
            }
        asm volatile("s_waitcnt lgkmcnt(0)" ::: "memory"); __builtin_amdgcn_s_barrier(); asm volatile("" ::: "memory");
#if defined(BROKEN_EXCHANGE_NO_WAIT)
#warning BROKEN CONTROL BUILD: the row-statistics exchange does not wait; results are wrong by design
        if (blockIdx.x >= 64) { const long long t0_ = clock64(); while (clock64() - t0_ < 60000) __builtin_amdgcn_s_sleep(8); }
#endif
        const int row = wid * 32 + (lane & 31);
        if (lane < 32) {
            const f32x2v a = P[row * 4 + 0], b = P[row * 4 + 1], c = P[row * 4 + 2], d = P[row * 4 + 3];
            const float mt = (a.x + b.x + c.x + d.x) * 0.25f;
            const float da = a.x - mt, db = b.x - mt, dc = c.x - mt, dd = d.x - mt;
            const float m2 = (a.y + b.y) + (c.y + d.y) + 64.0f * ((da * da + db * db) + (dc * dc + dd * dd));
            unsigned long long* slot = (unsigned long long*)xbuf + ((size_t)(u.pm * BM + row) * 4 + u.pn);
            __hip_atomic_store(slot, ((unsigned long long)__float_as_uint(m2) << 32) | __float_as_uint(mt), __ATOMIC_RELAXED, __HIP_MEMORY_SCOPE_AGENT);
        }
        asm volatile("s_waitcnt vmcnt(0)" ::: "memory");
        if (lane == 0) __hip_atomic_fetch_add(cnt + 64 * u.pm, 1u, __ATOMIC_RELAXED, __HIP_MEMORY_SCOPE_AGENT);
        if (wid == 0) {
            bool dead = false; const unsigned long long t0 = __builtin_amdgcn_s_memrealtime(); const unsigned want = 8u * (unsigned)ntn;
            for (;;) {
#if defined(BROKEN_EXCHANGE_NO_WAIT)
                break;
#endif
                if ((unsigned)__builtin_amdgcn_readfirstlane(__hip_atomic_load(cnt + 64 * u.pm, __ATOMIC_RELAXED, __HIP_MEMORY_SCOPE_AGENT)) >= want) break;
                if (__builtin_amdgcn_s_memrealtime() - t0 > 2000000ull) {
                    if (lane == 0) { unsigned expect = 0u; __hip_atomic_compare_exchange_strong(tmo + 1, &expect, code | (unsigned)(u.pm & 0xff), __ATOMIC_RELAXED, __ATOMIC_RELAXED, __HIP_MEMORY_SCOPE_AGENT);
                                     __hip_atomic_store(tmo, 1u, __ATOMIC_RELAXED, __HIP_MEMORY_SCOPE_AGENT); }
                    dead = true; break; }
                __builtin_amdgcn_s_sleep(2);
            }
            __builtin_amdgcn_fence(__ATOMIC_ACQUIRE, "agent");
            if (lane == 0) flag[0] = dead ? 1u : 0u;
        }
        asm volatile("s_waitcnt vmcnt(0) lgkmcnt(0)" ::: "memory"); __builtin_amdgcn_s_barrier(); asm volatile("" ::: "memory");
        const bool bad = flag[0] != 0u;
        if (lane < 32) {
            const unsigned long long* slot = (const unsigned long long*)xbuf + (size_t)(u.pm * BM + row) * 4; float mt[4], m2[4]; float ms = 0.f;
#pragma unroll
            for (int t = 0; t < 4; ++t) { if (t < ntn) { const unsigned long long w = __hip_atomic_load(slot + t, __ATOMIC_RELAXED, __HIP_MEMORY_SCOPE_AGENT); mt[t] = __uint_as_float((unsigned)w); m2[t] = __uint_as_float((unsigned)(w >> 32)); } else { mt[t] = 0.f; m2[t] = 0.f; } ms += mt[t]; }
            const float mean = ms / (float)ntn; float q = 0.f;
#pragma unroll
            for (int t = 0; t < 4; ++t) if (t < ntn) { const float dm = mt[t] - mean; q += m2[t] + 256.0f * dm * dm; }
            S[row] = (f32x2v){mean, 1.0f / sqrtf(q / (256.0f * (float)ntn) + eps)};
        }
        asm volatile("s_waitcnt lgkmcnt(0)" ::: "memory"); __builtin_amdgcn_s_barrier(); asm volatile("" ::: "memory");
        return bad;
    }
};
struct EpiLnRes {
    static constexpr bool PERM = false, AFTER_DRAIN = true;
    const float* base; float* out; int ldc; const float* bias; PanelStats st; unsigned poison;
    __device__ __forceinline__ void fused(f32x4 (&acc)[2][2][4][2], const Unit& u, int wr, int wc, int fr, int fq, PG8_LAS unsigned char* lds, int wid, int lane) const {
        typedef float f32x2v __attribute__((ext_vector_type(2)));
        const PG8_LAS f32x2v* S = (const PG8_LAS f32x2v*)(lds + 8192);
        const int col0 = u.pn * BM + wc * 32 + 4 * fq;
#pragma unroll
        for (int bj = 0; bj < 2; ++bj)
#pragma unroll
            for (int n = 0; n < 2; ++n) { const f32x4 bv = bias ? *(const f32x4*)(bias + col0 + bj * HALF + n * 16) : (f32x4){0.f, 0.f, 0.f, 0.f};
#pragma unroll
                for (int ai = 0; ai < 2; ++ai)
#pragma unroll
                    for (int m = 0; m < 4; ++m) acc[ai][bj][m][n] += bv; }
        f32x4 pre[4][2][2];
#pragma unroll
        for (int m = 0; m < 4; ++m) { const size_t off = (size_t)(u.pm * BM + wr * 64 + m * 16 + fr) * ldc + col0;
#pragma unroll
            for (int bj = 0; bj < 2; ++bj)
#pragma unroll
                for (int n = 0; n < 2; ++n) pre[m][bj][n] = *(const f32x4*)(base + off + bj * HALF + n * 16); }
        const bool bad = st.run(acc, u, wr, wc, fr, fq, lds, wid, lane) || poison != 0u;
        const float qnan = __builtin_nanf("");
#pragma unroll
        for (int ai = 0; ai < 2; ++ai)
#pragma unroll
            for (int m = 0; m < 4; ++m) { const int r = ai * HALF + wr * 64 + m * 16 + fr; const f32x2v sr = S[r]; const size_t off = (size_t)(u.pm * BM + r) * ldc + col0;
#pragma unroll
                for (int bj = 0; bj < 2; ++bj)
#pragma unroll
                    for (int n = 0; n < 2; ++n) { const f32x4 bs = ai == 0 ? pre[m][bj][n] : *(const f32x4*)(base + off + bj * HALF + n * 16); f32x4 o = bs + (acc[ai][bj][m][n] - sr.x) * sr.y;
                        if (bad) o = (f32x4){qnan, qnan, qnan, qnan}; *(f32x4*)(out + off + bj * HALF + n * 16) = o; }
                if (m & 1) asm volatile("" ::: "memory"); }
    }
};
struct EpiLnResLn {
    static constexpr bool PERM = false, AFTER_DRAIN = true;
    const float* base; float* out; bf16_t* xn; int ldc; const float* bias; PanelStats st1, st2; unsigned poison;
    __device__ __forceinline__ void fused(f32x4 (&acc)[2][2][4][2], const Unit& u, int wr, int wc, int fr, int fq, PG8_LAS unsigned char* lds, int wid, int lane) const {
        typedef float f32x2v __attribute__((ext_vector_type(2))); typedef unsigned u32x2v __attribute__((ext_vector_type(2)));
        const PG8_LAS f32x2v* S = (const PG8_LAS f32x2v*)(lds + 8192);
        const int col0 = u.pn * BM + wc * 32 + 4 * fq;
#pragma unroll
        for (int bj = 0; bj < 2; ++bj)
#pragma unroll
            for (int n = 0; n < 2; ++n) { const f32x4 bv = bias ? *(const f32x4*)(bias + col0 + bj * HALF + n * 16) : (f32x4){0.f, 0.f, 0.f, 0.f};
#pragma unroll
                for (int ai = 0; ai < 2; ++ai)
#pragma unroll
                    for (int m = 0; m < 4; ++m) acc[ai][bj][m][n] += bv; }
        bool bad = st1.run(acc, u, wr, wc, fr, fq, lds, wid, lane) || poison != 0u;
        const float qnan = __builtin_nanf("");
#pragma unroll
        for (int ai = 0; ai < 2; ++ai)
#pragma unroll
            for (int m = 0; m < 4; ++m) { const int r = ai * HALF + wr * 64 + m * 16 + fr; const f32x2v sr = S[r]; const size_t off = (size_t)(u.pm * BM + r) * ldc + col0;
#pragma unroll
                for (int bj = 0; bj < 2; ++bj)
#pragma unroll
                    for (int n = 0; n < 2; ++n) { const f32x4 bs = *(const f32x4*)(base + off + bj * HALF + n * 16); acc[ai][bj][m][n] = bs + (acc[ai][bj][m][n] - sr.x) * sr.y; }
                asm volatile("" : "+v"(acc[ai][0][m][0]), "+v"(acc[ai][0][m][1]), "+v"(acc[ai][1][m][0]), "+v"(acc[ai][1][m][1]));
                if (m & 1) asm volatile("" ::: "memory"); }
        const bool bad1 = bad;
        bad = st2.run(acc, u, wr, wc, fr, fq, lds, wid, lane) || bad;
#pragma unroll
        for (int ai = 0; ai < 2; ++ai)
#pragma unroll
            for (int m = 0; m < 4; ++m) { const int r = ai * HALF + wr * 64 + m * 16 + fr; const f32x2v sr = S[r]; const size_t off = (size_t)(u.pm * BM + r) * ldc + col0;
#pragma unroll
                for (int bj = 0; bj < 2; ++bj)
#pragma unroll
                    for (int n = 0; n < 2; ++n) { const f32x4 x1 = acc[ai][bj][m][n]; *(f32x4*)(out + off + bj * HALF + n * 16) = bad1 ? (f32x4){qnan, qnan, qnan, qnan} : x1;
                        const f32x4 o = (x1 - sr.x) * sr.y; u32x2v w; w.x = cvt_pk_bf16(o[0], o[1]); w.y = cvt_pk_bf16(o[2], o[3]);
                        if (bad) { w.x = 0x7fc07fc0u; w.y = 0x7fc07fc0u; } *(u32x2v*)(xn + off + bj * HALF + n * 16) = w; }
                asm volatile("" ::: "memory"); }
    }
};

template <class Epi, class Sched, bool ALIGN_EPI = false, bool SP2 = false>
__device__ __forceinline__ void gemm_phase(PG8_LAS unsigned char* lds, const Gemm g, const Sched& S, const Epi& E) {
    int tid_ = threadIdx.x; asm volatile("" : "+v"(tid_));
    const int tid = tid_, wid = __builtin_amdgcn_readfirstlane(tid >> 6), lane = tid & 63, wr = wid >> 2, wc = wid & 3, fr = lane & 15, fq = lane >> 4;
    const int K = g.K, nt = K / BK;
    unsigned voffA[2], voffB[2];
#pragma unroll
    for (int i = 0; i < 2; ++i) { int R, C; stage_rc(tid * 16 + i * 8192, R, C); const int Rb = Epi::PERM ? ((R & ~31) + perm32(R & 31)) : R;
        voffA[i] = (unsigned)(R * K + C) * 2u; voffB[i] = (unsigned)(Rb * K + C) * 2u; }
    const size_t kstep = (size_t)(BK * 2);
    const size_t hstep = (size_t)HALF * K * 2;
    const size_t tstep = 2 * hstep;
    const unsigned ldsw = (unsigned)wid * 1024u;
    const int aoff = lds_byte(wr * 64 + fr, fq * 8), boff = lds_byte(wc * 32 + fr, fq * 8);
#define PG8_SA(b, h) (((b) * 2 + (h)) * HTB)
#define PG8_SB(b, h) ((4 + (b) * 2 + (h)) * HTB)
#define PG8_STAGE(bufoff, gbase, voff) do { _Pragma("unroll") for (int _i = 0; _i < 2; ++_i) \
        __builtin_amdgcn_global_load_lds((const unsigned*)((const char*)(gbase) + (voff)[_i]), (PG8_LAS unsigned*)(lds + (bufoff) + ldsw + _i * 8192), 16, 0, 0); } while (0)
#define PG8_LDA(dst, b, h) do { _Pragma("unroll") for (int m = 0; m < 4; ++m) _Pragma("unroll") for (int k = 0; k < 2; ++k) dst[m][k] = *(const PG8_LAS bf16x8*)(lds + PG8_SA(b, h) + aoff + m * 2048 + k * 1024); } while (0)
#define PG8_LDB(dst, b, h) do { _Pragma("unroll") for (int n = 0; n < 2; ++n) _Pragma("unroll") for (int k = 0; k < 2; ++k) dst[n][k] = *(const PG8_LAS bf16x8*)(lds + PG8_SB(b, h) + boff + n * 2048 + k * 1024); } while (0)
#define PG8_MMA(ai, bj, At, Bt) do { __builtin_amdgcn_s_setprio(1); _Pragma("unroll") for (int m = 0; m < 4; ++m) _Pragma("unroll") for (int n = 0; n < 2; ++n) _Pragma("unroll") for (int k = 0; k < 2; ++k) \
        acc[ai][bj][m][n] = __builtin_amdgcn_mfma_f32_16x16x32_bf16(Bt[n][k], At[m][k], acc[ai][bj][m][n], 0, 0, 0); __builtin_amdgcn_s_setprio(0); } while (0)
#define PG8_WAIT_V(n) asm volatile("s_waitcnt vmcnt(" #n ")" ::: "memory")
#define PG8_WAIT_L(n) asm volatile("s_waitcnt lgkmcnt(" #n ")" ::: "memory")
#define PG8_BAR __builtin_amdgcn_s_barrier()
#define PG8_SCHED __builtin_amdgcn_sched_barrier(0)
    Unit cur, nxt; int ui = 0;
    if (!S.next(0, cur)) return;
    f32x4 acc[2][2][4][2];
#pragma unroll
    for (int a = 0; a < 2; ++a)
#pragma unroll
        for (int b = 0; b < 2; ++b)
#pragma unroll
            for (int m = 0; m < 4; ++m)
#pragma unroll
                for (int n = 0; n < 2; ++n) acc[a][b][m][n] = (f32x4){0.f, 0.f, 0.f, 0.f};
    bf16x8 At[4][2], B0[2][2], B1[2][2];
    const char* cA = (const char*)g.A + (size_t)cur.pm * tstep; const char* cB = (const char*)g.Bt + (size_t)cur.pn * tstep;
    S.a_ready(cur);
    if constexpr (SP2) {
        PG8_STAGE(PG8_SB(0, 0), cB, voffB); PG8_STAGE(PG8_SB(0, 1), cB + hstep, voffB); PG8_STAGE(PG8_SA(0, 0), cA, voffA); PG8_STAGE(PG8_SA(0, 1), cA + hstep, voffA);
        if (wr == 1) PG8_BAR;
        PG8_WAIT_V(2); PG8_BAR;
        PG8_STAGE(PG8_SB(1, 0), cB + kstep, voffB); PG8_STAGE(PG8_SA(1, 0), cA + kstep, voffA); PG8_STAGE(PG8_SB(1, 1), cB + hstep + kstep, voffB);
        PG8_WAIT_V(6); PG8_BAR;
    } else {
        PG8_STAGE(PG8_SB(0, 0), cB, voffB); PG8_STAGE(PG8_SA(0, 0), cA, voffA); PG8_STAGE(PG8_SB(0, 1), cB + hstep, voffB); PG8_STAGE(PG8_SA(0, 1), cA + hstep, voffA);
        if (wr == 1) PG8_BAR;
        PG8_WAIT_V(4); PG8_BAR;
        PG8_STAGE(PG8_SB(1, 0), cB + kstep, voffB); PG8_STAGE(PG8_SA(1, 0), cA + kstep, voffA); PG8_STAGE(PG8_SB(1, 1), cB + hstep + kstep, voffB);
        PG8_WAIT_V(6); PG8_BAR;
    }
    for (;;) {
        const bool has_next = S.next(ui + 1, nxt);
        const char* nA = has_next ? (const char*)g.A + (size_t)nxt.pm * tstep : cA; const char* nB = has_next ? (const char*)g.Bt + (size_t)nxt.pn * tstep : cB;
        for (int t = 0; t < nt; t += 2) {
            const bool last = (t == nt - 2);
            const char* a1 = cA + (size_t)(t + 1) * kstep;
            const char* a2 = last ? nA : cA + (size_t)(t + 2) * kstep; const char* b2 = last ? nB : cB + (size_t)(t + 2) * kstep;
            const char* a3 = a2 + kstep; const char* b3 = b2 + kstep;
            if (last && has_next) S.a_ready(nxt);
            if constexpr (SP2) {
            PG8_LDB(B0, 0, 0); PG8_LDB(B1, 0, 1); PG8_SCHED; PG8_LDA(At, 0, 0); PG8_STAGE(PG8_SA(1, 1), a1 + hstep, voffA);
            PG8_WAIT_V(8); PG8_WAIT_L(0); PG8_BAR; PG8_MMA(0, 0, At, B0); PG8_MMA(0, 1, At, B1); PG8_BAR; PG8_SCHED;
            PG8_LDA(At, 0, 1); PG8_STAGE(PG8_SB(0, 0), b2, voffB); PG8_STAGE(PG8_SB(0, 1), b2 + hstep, voffB); PG8_STAGE(PG8_SA(0, 0), a2, voffA);
            PG8_WAIT_V(8); PG8_WAIT_L(0); PG8_BAR; PG8_MMA(1, 0, At, B0); PG8_MMA(1, 1, At, B1); PG8_BAR; PG8_SCHED;
            PG8_LDB(B0, 1, 0); PG8_LDB(B1, 1, 1); PG8_SCHED; PG8_LDA(At, 1, 0); PG8_STAGE(PG8_SA(0, 1), a2 + hstep, voffA);
            PG8_WAIT_V(8); PG8_WAIT_L(0); PG8_BAR; PG8_MMA(0, 0, At, B0); PG8_MMA(0, 1, At, B1); PG8_BAR; PG8_SCHED;
            PG8_LDA(At, 1, 1); PG8_STAGE(PG8_SB(1, 0), b3, voffB); PG8_STAGE(PG8_SB(1, 1), b3 + hstep, voffB); PG8_STAGE(PG8_SA(1, 0), a3, voffA);
            PG8_WAIT_V(8); PG8_WAIT_L(0); PG8_BAR; PG8_MMA(1, 0, At, B0); PG8_MMA(1, 1, At, B1); PG8_BAR; PG8_SCHED;
            } else {
            PG8_LDB(B0, 0, 0); PG8_SCHED; PG8_LDA(At, 0, 0); PG8_STAGE(PG8_SA(1, 1), a1 + hstep, voffA);
            PG8_WAIT_L(8); PG8_BAR; PG8_WAIT_L(0); PG8_MMA(0, 0, At, B0); PG8_BAR; PG8_SCHED;
            PG8_LDB(B1, 0, 1); PG8_STAGE(PG8_SB(0, 0), b2, voffB);
            PG8_BAR; PG8_WAIT_L(0); PG8_MMA(0, 1, At, B1); PG8_BAR;
            PG8_LDA(At, 0, 1); PG8_STAGE(PG8_SA(0, 0), a2, voffA);
            PG8_BAR; PG8_WAIT_L(0); PG8_MMA(1, 0, At, B0); PG8_BAR; PG8_SCHED;
            PG8_STAGE(PG8_SB(0, 1), b2 + hstep, voffB);
            PG8_WAIT_V(6); PG8_BAR; PG8_MMA(1, 1, At, B1); PG8_BAR;
            PG8_LDB(B0, 1, 0); PG8_SCHED; PG8_LDA(At, 1, 0); PG8_STAGE(PG8_SA(0, 1), a2 + hstep, voffA);
            PG8_WAIT_L(8); PG8_BAR; PG8_WAIT_L(0); PG8_MMA(0, 0, At, B0); PG8_BAR; PG8_SCHED;
            PG8_LDB(B1, 1, 1); PG8_STAGE(PG8_SB(1, 0), b3, voffB);
            PG8_BAR; PG8_WAIT_L(0); PG8_MMA(0, 1, At, B1); PG8_BAR;
            PG8_LDA(At, 1, 1); PG8_STAGE(PG8_SA(1, 0), a3, voffA);
            PG8_BAR; PG8_WAIT_L(0); PG8_MMA(1, 0, At, B0); PG8_BAR; PG8_SCHED;
            PG8_STAGE(PG8_SB(1, 1), b3 + hstep, voffB);
            PG8_WAIT_V(6); PG8_BAR; PG8_MMA(1, 1, At, B1); PG8_BAR;
            }
        }
        if constexpr (ALIGN_EPI) { if (wr == 0) PG8_BAR; }
        if constexpr (!Epi::AFTER_DRAIN) { E(acc, cur, wr, wc, fr, fq); S.done(cur); }
        if (!has_next) break;
#pragma unroll
        for (int a = 0; a < 2; ++a)
#pragma unroll
            for (int b = 0; b < 2; ++b)
#pragma unroll
                for (int m = 0; m < 4; ++m)
#pragma unroll
                    for (int n = 0; n < 2; ++n) acc[a][b][m][n] = (f32x4){0.f, 0.f, 0.f, 0.f};
        cur = nxt; cA = nA; cB = nB; ++ui;
        if constexpr (ALIGN_EPI) { if (wr == 1) PG8_BAR; }
    }
    PG8_WAIT_V(0);
    if constexpr (!ALIGN_EPI) { if (wr == 0) PG8_BAR; }
    PG8_BAR;
    if constexpr (Epi::AFTER_DRAIN) { E.fused(acc, cur, wr, wc, fr, fq, lds, wid, lane); S.done(cur); }
#undef PG8_SA
#undef PG8_SB
#undef PG8_STAGE
#undef PG8_LDA
#undef PG8_LDB
#undef PG8_MMA
#undef PG8_WAIT_V
#undef PG8_WAIT_L
#undef PG8_BAR
#undef PG8_SCHED
}
}

#ifndef PG8_SP2
#define PG8_SP2 true
#endif
#ifndef PG8_ALIGN
#define PG8_ALIGN true
#endif
#include <hip/hip_bf16.h>
#include <cmath>
namespace attn_body {
using bf16=__hip_bfloat16;
using bf16x8=__attribute__((ext_vector_type(8)))short;
using s16x4=__attribute__((ext_vector_type(4)))short;
using f32x16=__attribute__((ext_vector_type(16)))float;
using u32x4=__attribute__((ext_vector_type(4)))unsigned;
constexpr int BATCH=2,NHEAD=16,SEQ=8192,D=64,DM=NHEAD*D;
constexpr int NW=8,QBLK=32,QB=QBLK*NW,KVBLK=64,NQB=SEQ/QB;
constexpr int ATTN_PITCH=DM, ATTN_UNIT_ROWS=QB, OPITCH=2048;
__device__ __forceinline__ int crow(int r,int hi){return (r&3)+8*(r>>2)+4*hi;}
#define SBAR() __builtin_amdgcn_sched_barrier(0)
__device__ __forceinline__ void cmask(f32x16&p0,f32x16&p1,int jb,int qrel,int hi){
  const float NEG=-INFINITY; int kb=64*jb+4*hi;
  #pragma unroll
  for(int r=0;r<16;++r){int kv=kb+(r&3)+8*(r>>2); if(kv>qrel)p0[r]=NEG; if(kv+32>qrel)p1[r]=NEG;}
}

constexpr int NSLOT=3, SLOTB=8192;
constexpr int LDS_K=0, LDS_V=NSLOT*SLOTB, LDS_WS=2*NSLOT*SLOTB, LDS_OST=LDS_WS+NW*64*4, LDS_BYTES=LDS_OST+NW*4096;
constexpr float C2=0.125f*1.4426950408889634f;
__device__ __forceinline__ void glds16(const void*gsrc,unsigned lds_dst){unsigned keep;
  asm volatile("s_mov_b32 %0, m0\n\ts_mov_b32 m0, %2\n\ts_nop 0\n\tglobal_load_lds_dwordx4 %1, off\n\ts_mov_b32 m0, %0":"=&s"(keep):"v"(gsrc),"s"(lds_dst):"memory");}
__device__ __forceinline__ float max3f(float a,float b,float c){float r;asm("v_max3_f32 %0, %1, %2, %3":"=v"(r):"v"(a),"v"(b),"v"(c));return r;}
__device__ __forceinline__ float max2f(float a,float b){float r;asm("v_max_f32_e32 %0, %1, %2":"=v"(r):"v"(a),"v"(b));return r;}
__device__ __forceinline__ float fadd_s(float a,float b){float r;asm("v_add_f32_e32 %0, %1, %2":"=v"(r):"v"(a),"v"(b));return r;}
__device__ __forceinline__ float fsub_s(float a,float b){float r;asm("v_sub_f32_e32 %0, %1, %2":"=v"(r):"v"(a),"v"(b));return r;}
typedef float f32x2_t __attribute__((ext_vector_type(2))); typedef __bf16 bf16x2_t __attribute__((ext_vector_type(2)));
__device__ __forceinline__ unsigned cvtpk_s(float lo,float hi){f32x2_t v={lo,hi};bf16x2_t b=__builtin_convertvector(v,bf16x2_t);return __builtin_bit_cast(unsigned,b);}
#define WAIT_BAR(N) asm volatile("s_waitcnt vmcnt(" #N ") lgkmcnt(0)\n\ts_barrier":::"memory")

__device__ __forceinline__ void qkt(f32x16&p0,f32x16&p1,const char*Kslot,const bf16x8*qr,const f32x16&negm,int r32,int hi){
  const char*kb=Kslot+hi*1024+r32*16;
  #pragma unroll
  for(int d0=0;d0<4;++d0){
    const bf16x8 b0=*reinterpret_cast<const bf16x8*>(kb+d0*2048);
    const bf16x8 b1=*reinterpret_cast<const bf16x8*>(kb+d0*2048+512);
    if(d0==0){p0=__builtin_amdgcn_mfma_f32_32x32x16_bf16(b0,qr[0],negm,0,0,0);p1=__builtin_amdgcn_mfma_f32_32x32x16_bf16(b1,qr[0],negm,0,0,0);}
    else{p0=__builtin_amdgcn_mfma_f32_32x32x16_bf16(b0,qr[d0],p0,0,0,0);p1=__builtin_amdgcn_mfma_f32_32x32x16_bf16(b1,qr[d0],p1,0,0,0);}}
}
typedef __attribute__((address_space(3))) const char* lds_cptr;
typedef short v4i16_t __attribute__((ext_vector_type(4)));
__device__ __forceinline__ void kload8(bf16x8*kf,lds_cptr kp){
  kf[0]=*(const __attribute__((address_space(3))) bf16x8*)(kp);      kf[1]=*(const __attribute__((address_space(3))) bf16x8*)(kp+512);
  kf[2]=*(const __attribute__((address_space(3))) bf16x8*)(kp+2048); kf[3]=*(const __attribute__((address_space(3))) bf16x8*)(kp+2560);
  kf[4]=*(const __attribute__((address_space(3))) bf16x8*)(kp+4096); kf[5]=*(const __attribute__((address_space(3))) bf16x8*)(kp+4608);
  kf[6]=*(const __attribute__((address_space(3))) bf16x8*)(kp+6144); kf[7]=*(const __attribute__((address_space(3))) bf16x8*)(kp+6656);
}
__device__ __forceinline__ void kload2(bf16x8*kf,lds_cptr kp,int j){ kf[2*j]=*(const __attribute__((address_space(3))) bf16x8*)(kp+j*2048); kf[2*j+1]=*(const __attribute__((address_space(3))) bf16x8*)(kp+j*2048+512); }
__device__ __forceinline__ s16x4 vtr(lds_cptr p){ return __builtin_bit_cast(s16x4,__builtin_amdgcn_ds_read_tr16_b64_v4i16((__attribute__((address_space(3))) v4i16_t*)p)); }
__device__ __forceinline__ float rowmax(const f32x16&p0,const f32x16&p1){
  float a=max3f(p0[0],p0[1],p1[0]),b=max3f(p0[2],p0[3],p1[1]);a=max3f(a,p1[2],p1[3]);
  #pragma unroll
  for(int r=4;r<16;r+=4){a=max3f(a,p0[r],p0[r+1]);b=max3f(b,p0[r+2],p0[r+3]);a=max3f(a,p1[r],p1[r+1]);b=max3f(b,p1[r+2],p1[r+3]);}
  const float m=max2f(a,b);
  auto rr=__builtin_amdgcn_permlane32_swap(__float_as_uint(m),__float_as_uint(m),false,false);
  return max2f(__uint_as_float(rr[0]),__uint_as_float(rr[1]));
}
__device__ __forceinline__ void pv(f32x16*o,int vb,bf16x8 pa0,bf16x8 pa1,bf16x8 pa2,bf16x8 pa3){
  #pragma unroll
  for(int d0=0;d0<2;++d0){s16x4 lo[4],hi[4];
    #pragma unroll
    for(int ks=0;ks<4;++ks){
      asm volatile("ds_read_b64_tr_b16 %0,%1 offset:%c2":"=&v"(lo[ks]):"v"(vb),"i"(d0*4096+ks*1024):"memory");
      asm volatile("ds_read_b64_tr_b16 %0,%1 offset:%c2":"=&v"(hi[ks]):"v"(vb),"i"(d0*4096+ks*1024+512):"memory");}
    asm volatile("s_waitcnt lgkmcnt(0)":::"memory");SBAR();
    #define PK(k) (bf16x8){lo[k][0],lo[k][1],lo[k][2],lo[k][3],hi[k][0],hi[k][1],hi[k][2],hi[k][3]}
    o[d0]=__builtin_amdgcn_mfma_f32_32x32x16_bf16(pa0,PK(0),o[d0],0,0,0);
    o[d0]=__builtin_amdgcn_mfma_f32_32x32x16_bf16(pa1,PK(1),o[d0],0,0,0);
    o[d0]=__builtin_amdgcn_mfma_f32_32x32x16_bf16(pa2,PK(2),o[d0],0,0,0);
    o[d0]=__builtin_amdgcn_mfma_f32_32x32x16_bf16(pa3,PK(3),o[d0],0,0,0);
    #undef PK
  }
}

#ifndef ATTN_STORE16
#define ATTN_STORE16(p,v) (*(u32x4*)(p)=(v))
#endif
template<int THRL> __device__ __forceinline__ void attn_unit(int b,int vh,int qb,const bf16*Q,const bf16*__restrict__ K,const bf16*__restrict__ V,bf16*O,char*shm){
  const int hq=(vh>>2)*128+((vh>>1)&1)*64, hv=(vh>>2)*128+(vh&1)*64, ho=((vh>>1)&1)*1024+(vh>>2)*128+(vh&1)*64;
  int tid_=threadIdx.x; asm volatile("":"+v"(tid_)); const int tid=tid_,lane=tid&63,r32=lane&31,hi=lane>>5; const int wid=__builtin_amdgcn_readfirstlane(tid>>6);
  const long rowbase=(long)b*SEQ; const int q0=qb*QB;
  const bf16*Qw=Q+(rowbase+q0+wid*QBLK)*DM+hq;
  const bf16*Kh=K+rowbase*DM+hq,*Vh=V+rowbase*DM+hv;
  const unsigned lds0=(unsigned)(uintptr_t)shm;
  float*wsf=(float*)(shm+LDS_WS)+wid*64;
  const bf16*ksrc=Kh+(long)lane*DM+wid*8;
  const bf16*vsrc=Vh+(long)(16*(wid&3)+(lane>>2))*DM+(wid>>2)*32+(lane&3)*8;
  const unsigned kdst=lds0+LDS_K+wid*1024, vdst=lds0+LDS_V+wid*1024;
  #define DMA_K(t,slot) glds16(ksrc+(long)(t)*KVBLK*DM,(unsigned)__builtin_amdgcn_readfirstlane(kdst+(slot)))
  #define DMA_V(t,slot) glds16(vsrc+(long)(t)*KVBLK*DM,(unsigned)__builtin_amdgcn_readfirstlane(vdst+(slot)))
  const int vb0=(int)(lds0+LDS_V)+((lane>>4)&1)*32+(lane&3)*8+(4*hi+((lane&15)>>2))*64;
  const char*Kbase=shm+LDS_K; bf16x8 kf[8];
  const lds_cptr shm3=(lds_cptr)shm; const lds_cptr kp0=shm3+LDS_K+hi*1024+r32*16; const lds_cptr vp0=shm3+LDS_V+((lane>>4)&1)*32+(lane&3)*8+(4*hi+((lane&15)>>2))*64;
  const int NT=(q0+QB)/KVBLK;
  DMA_K(0,0);DMA_V(0,0);DMA_K(1,SLOTB);
  bf16x8 qr[4];
  #pragma unroll
  for(int d0=0;d0<4;++d0)qr[d0]=*reinterpret_cast<const bf16x8*>(&Qw[(long)r32*DM+d0*16+hi*8]);
  float mhat=0.f,l_reg=0.f;f32x16 o[2];o[0]=f32x16{};o[1]=f32x16{};f32x16 negm=f32x16{};asm volatile("":"+v"(negm));
  const int qrel=(wid*QBLK+r32)|63;
  #define CMASK(P0,P1,t) do{int jb_=(t)-(NT-4); if(jb_>=0)cmask(P0,P1,jb_,qrel,hi);}while(0)
  bool resc=false;
  #define START(P0,P1) do{ const float rm=rowmax(P0,P1); resc=false; \
    { const float dl=rm; mhat=fadd_s(mhat,dl); \
      _Pragma("unroll") for(int r=0;r<16;++r){P0[r]=fsub_s(P0[r],dl);P1[r]=fsub_s(P1[r],dl);} \
      _Pragma("unroll") for(int r=0;r<16;++r)negm[r]=-mhat; asm volatile("":"+v"(negm)); } \
    _Pragma("unroll") for(int r=0;r<16;++r)P0[r]=__builtin_amdgcn_exp2f(P0[r]); }while(0)
  #define RESC() do{ if(resc){ asm volatile("s_waitcnt lgkmcnt(0)":::"memory"); \
      _Pragma("unroll") for(int d_=0;d_<2;++d_) _Pragma("unroll") for(int r=0;r<16;++r)o[d_][r]*=wsf[crow(r,hi)]; } }while(0)
  f32x16 pA0,pA1,pB0,pB1;
  int sl_prev=0,sl_cur=0,sl_next=SLOTB;
  #define ROT() do{sl_prev=sl_cur;sl_cur=sl_next;sl_next=(sl_next==(NSLOT-1)*SLOTB)?0:sl_next+SLOTB;}while(0)
  DMA_K(2,2*SLOTB);
  WAIT_BAR(3);
  qkt(pA0,pA1,Kbase,qr,negm,r32,hi);asm volatile("s_nop 15\n\ts_nop 7":"+v"(pA0),"+v"(pA1));CMASK(pA0,pA1,0);
  START(pA0,pA1);
  _Pragma("unroll") for(int r=0;r<16;++r)pA1[r]=__builtin_amdgcn_exp2f(pA1[r]);
  WAIT_BAR(0);
  DMA_K(3,0);DMA_V(1,SLOTB);
  ROT();
  kload8(kf,kp0+sl_cur);
  WAIT_BAR(2);
  s16x4 vlo[8],vhi[8]; u32x4 pw0,pw1,pw2,pw3;
  #define PKW(P,B) cvtpk_s(P[B],P[B+1])
  #define PAF(k) __builtin_bit_cast(bf16x8,pw##k)
  #define VFR(i) (bf16x8){vlo[i][0],vlo[i][1],vlo[i][2],vlo[i][3],vhi[i][0],vhi[i][1],vhi[i][2],vhi[i][3]}
  #define PIN(x) asm volatile("":"+v"(x))
  #define MX3(a,b,c) __builtin_fmaxf(__builtin_fmaxf((a),(b)),(c))
  #define GAPA(MF,A0,A1,A2,A3,W0,W1,PW) do{ MF; sacc+=A0; sacc+=A1; sacc+=A2; sacc+=A3; PIN(sacc); W0; W1; PIN(PW); SBAR(); }while(0)
  #define EX(v) __builtin_amdgcn_exp2f(v)
  #define GAPB(MF,X,B) do{ MF; X[B]=EX(X[B]); X[B+1]=EX(X[B+1]); X[B+2]=EX(X[B+2]); X[B+3]=EX(X[B+3]); PIN(X); SBAR(); }while(0)
  #define VRD(i) do{ vlo[i]=vtr(vp_+(((i)>>2)*4096+((i)&3)*1024)); vhi[i]=vtr(vp_+(((i)>>2)*4096+((i)&3)*1024+512)); }while(0)
  #define KRD(G,j) do{ if(G){ kload2(kf,kp0+sl_next,j); SBAR(); } }while(0)
  #define STEP(C0,C1,P0,P1,t,GK,GV,GL) do{ SBAR(); \
    const lds_cptr vp_=vp0+sl_prev; \
    VRD(0); SBAR(); float sacc=(P0[0]+P0[1]); \
    GAPA(C0=__builtin_amdgcn_mfma_f32_32x32x16_bf16(kf[0],qr[0],negm,0,0,0), P0[2],P0[3],P0[4],P0[5],     pw0[0]=PKW(P0,0), pw0[1]=PKW(P0,2), pw0); \
    VRD(4); SBAR(); GAPA(C1=__builtin_amdgcn_mfma_f32_32x32x16_bf16(kf[1],qr[0],negm,0,0,0), P0[6],P0[7],P0[8],P0[9],     pw0[2]=PKW(P0,4), pw0[3]=PKW(P0,6), pw0); \
    VRD(1); SBAR(); GAPA(C0=__builtin_amdgcn_mfma_f32_32x32x16_bf16(kf[2],qr[1],C0,0,0,0),   P0[10],P0[11],P0[12],P0[13], pw1[0]=PKW(P0,8), pw1[1]=PKW(P0,10), pw1); \
    VRD(5); SBAR(); GAPA(C1=__builtin_amdgcn_mfma_f32_32x32x16_bf16(kf[3],qr[1],C1,0,0,0),   P0[14],P0[15],P1[0],P1[1],   pw1[2]=PKW(P0,12),pw1[3]=PKW(P0,14), pw1); \
    VRD(2); SBAR(); GAPA(C0=__builtin_amdgcn_mfma_f32_32x32x16_bf16(kf[4],qr[2],C0,0,0,0),   P1[2],P1[3],P1[4],P1[5],     pw2[0]=PKW(P1,0), pw2[1]=PKW(P1,2), pw2); \
    VRD(6); SBAR(); GAPA(C1=__builtin_amdgcn_mfma_f32_32x32x16_bf16(kf[5],qr[2],C1,0,0,0),   P1[6],P1[7],P1[8],P1[9],     pw2[2]=PKW(P1,4), pw2[3]=PKW(P1,6), pw2); \
    VRD(3); SBAR(); GAPA(C0=__builtin_amdgcn_mfma_f32_32x32x16_bf16(kf[6],qr[3],C0,0,0,0),   P1[10],P1[11],P1[12],P1[13], pw3[0]=PKW(P1,8), pw3[1]=PKW(P1,10), pw3); \
    VRD(7); SBAR(); GAPA(C1=__builtin_amdgcn_mfma_f32_32x32x16_bf16(kf[7],qr[3],C1,0,0,0),   P1[14],P1[15],0.f,0.f,       pw3[2]=PKW(P1,12),pw3[3]=PKW(P1,14), pw3); \
    l_reg+=sacc; \
    if(GK){DMA_K((t)+3,sl_cur);} if(GV){DMA_V((t)+1,sl_next);} \
    CMASK(C0,C1,t); \
    { float a=MX3(C0[0],C0[1],C1[0]),b=MX3(C0[2],C0[3],C1[1]); a=MX3(a,C1[2],C1[3]); \
      _Pragma("unroll") for(int r=4;r<16;r+=4){a=MX3(a,C0[r],C0[r+1]);b=MX3(b,C0[r+2],C0[r+3]);a=MX3(a,C1[r],C1[r+1]);b=MX3(b,C1[r+2],C1[r+3]);} \
      float rm=__builtin_fmaxf(a,b); { auto rr=__builtin_amdgcn_permlane32_swap(__float_as_uint(rm),__float_as_uint(rm),false,false); rm=__builtin_fmaxf(__uint_as_float(rr[0]),__uint_as_float(rr[1])); } \
      resc=false; \
      if(__builtin_expect(__any(rm>(float)THRL),0)){ const float dl=__builtin_fmaxf(rm,0.f); mhat+=dl; \
        _Pragma("unroll") for(int r=0;r<16;++r){C0[r]-=dl;C1[r]-=dl;} \
        _Pragma("unroll") for(int r=0;r<16;++r)negm[r]=-mhat; asm volatile("":"+v"(negm)); \
        const float f=__builtin_amdgcn_exp2f(-dl); l_reg*=f; if(hi==0)wsf[r32]=f; resc=true; } } \
    SBAR(); \
    GAPB(o[0]=__builtin_amdgcn_mfma_f32_32x32x16_bf16(PAF(0),VFR(0),o[0],0,0,0), C0,0); \
    GAPB(o[1]=__builtin_amdgcn_mfma_f32_32x32x16_bf16(PAF(0),VFR(4),o[1],0,0,0), C0,4); \
    KRD(GL,0); GAPB(o[0]=__builtin_amdgcn_mfma_f32_32x32x16_bf16(PAF(1),VFR(1),o[0],0,0,0), C0,8); \
    KRD(GL,1); GAPB(o[1]=__builtin_amdgcn_mfma_f32_32x32x16_bf16(PAF(1),VFR(5),o[1],0,0,0), C0,12); \
    KRD(GL,2); GAPB(o[0]=__builtin_amdgcn_mfma_f32_32x32x16_bf16(PAF(2),VFR(2),o[0],0,0,0), C1,0); \
    KRD(GL,3); GAPB(o[1]=__builtin_amdgcn_mfma_f32_32x32x16_bf16(PAF(2),VFR(6),o[1],0,0,0), C1,4); \
    GAPB(o[0]=__builtin_amdgcn_mfma_f32_32x32x16_bf16(PAF(3),VFR(3),o[0],0,0,0), C1,8); \
    GAPB(o[1]=__builtin_amdgcn_mfma_f32_32x32x16_bf16(PAF(3),VFR(7),o[1],0,0,0), C1,12); \
    }while(0)
  int t=1;
  #undef CMASK
  #define CMASK(P0,P1,t) do{}while(0)
  for(;t+5<NT;t+=2){
    STEP(pB0,pB1,pA0,pA1,t,true,true,true);     WAIT_BAR(2); RESC(); ROT();
    STEP(pA0,pA1,pB0,pB1,t+1,true,true,true);   WAIT_BAR(2); RESC(); ROT();
  }
  #undef CMASK
  #define CMASK(P0,P1,t) do{int jb_=(t)-(NT-4); if(jb_>=0)cmask(P0,P1,jb_,qrel,hi);}while(0)
  #define ENDW(tt) do{ if((tt)+3<NT){WAIT_BAR(2);} else if((tt)+2<NT){WAIT_BAR(1);} else {WAIT_BAR(0);} }while(0)
  for(;t+1<NT;t+=2){
    STEP(pB0,pB1,pA0,pA1,t,(t+3<NT),(t+1<NT),(t+1<NT));       ENDW(t);   RESC(); ROT();
    STEP(pA0,pA1,pB0,pB1,t+1,(t+4<NT),(t+2<NT),(t+2<NT));     ENDW(t+1); RESC(); ROT();
  }
  STEP(pB0,pB1,pA0,pA1,NT-1,false,false,false); RESC();
  { float sacc=pB0[0]+pB0[1]; _Pragma("unroll") for(int r=2;r<16;++r)sacc+=pB0[r]; _Pragma("unroll") for(int r=0;r<16;++r)sacc+=pB1[r]; l_reg+=sacc;
    pw0=(u32x4){PKW(pB0,0),PKW(pB0,2),PKW(pB0,4),PKW(pB0,6)};pw1=(u32x4){PKW(pB0,8),PKW(pB0,10),PKW(pB0,12),PKW(pB0,14)};pw2=(u32x4){PKW(pB1,0),PKW(pB1,2),PKW(pB1,4),PKW(pB1,6)};pw3=(u32x4){PKW(pB1,8),PKW(pB1,10),PKW(pB1,12),PKW(pB1,14)};
    SBAR(); pv(o,vb0+sl_cur,PAF(0),PAF(1),PAF(2),PAF(3)); }
  #undef PKW
  #undef PAF
  #undef VFR
  #undef PIN
  #undef MX3
  #undef GAPA
  #undef GAPB
  #undef EX
  #undef VRD
  #undef KRD
  #undef STEP
  #undef ENDW
  {auto rr=__builtin_amdgcn_permlane32_swap(__float_as_uint(l_reg),__float_as_uint(l_reg),false,false);l_reg=__uint_as_float(rr[0])+__uint_as_float(rr[1]);}
  if(hi==0)wsf[32+r32]=l_reg;asm volatile("s_waitcnt lgkmcnt(0)":::"memory");
  float rli[16];
  #pragma unroll
  for(int r=0;r<16;++r)rli[r]=__builtin_amdgcn_rcpf(wsf[32+crow(r,hi)]);
  bf16*Ow=O+(rowbase+q0+wid*QBLK)*OPITCH+ho;
  { bf16*stg=(bf16*)(shm+LDS_OST)+wid*2048;
    #pragma unroll
    for(int r=0;r<16;++r){const int orow=crow(r,hi);
      #pragma unroll
      for(int d0=0;d0<2;++d0)stg[orow*64+d0*32+r32]=__float2bfloat16(o[d0][r]*rli[r]);}
    asm volatile("s_waitcnt lgkmcnt(0)":::"memory");
    #pragma unroll
    for(int i=0;i<4;++i){const int row=i*8+(lane>>3),ch=lane&7; const u32x4 v=*(const u32x4*)(stg+row*64+ch*8); ATTN_STORE16(Ow+(long)row*OPITCH+ch*8,v);} }
  asm volatile("s_waitcnt lgkmcnt(0)\n\ts_barrier":::"memory");
  #undef DMA_K
  #undef DMA_V
  #undef CMASK
  #undef START
  #undef RESC
  #undef ROT
}
constexpr int ATTN_LDS_BYTES=LDS_BYTES;
struct AttnTensors { const bf16* Q; const bf16* K; const bf16* V; bf16* O; };
struct AttnUnit { int bh; int qb; };
struct StaticOrder {
  int vcu;
  __device__ __forceinline__ explicit StaticOrder(int grid,int block):vcu((block%8)*(grid/8)+block/8){}
  __device__ __forceinline__ bool next(int i,AttnUnit&u)const{ if(i>=8)return false; const int s=vcu&7,ii=i&3; u.bh=(vcu>>3)+32*(i>>2); u.qb=(ii==0)?s:(ii==1)?15-s:(ii==2)?16+s:31-s; return true; }
  __device__ __forceinline__ void a_ready(const AttnUnit&)const{}
  __device__ __forceinline__ void done(const AttnUnit&)const{}
};
template<class Sched,int THRL=8> __device__ __forceinline__ void attn_phase(char*lds,const AttnTensors&T,const Sched&S){
  AttnUnit u;
  for(int i=0;S.next(i,u);++i){ S.a_ready(u); attn_unit<THRL>(u.bh>>5,u.bh&31,u.qb,T.Q,T.K,T.V,T.O,lds); S.done(u); }
}
#undef SBAR
#undef WAIT_BAR
}

#define DI __device__ __forceinline__
#define LAS __attribute__((address_space(3)))
typedef unsigned short bf16_t;
typedef short bf16x8 __attribute__((ext_vector_type(8)));
typedef short s16x4 __attribute__((ext_vector_type(4)));
typedef float f32x4 __attribute__((ext_vector_type(4)));
typedef float f32x16 __attribute__((ext_vector_type(16)));
typedef unsigned u32x4 __attribute__((ext_vector_type(4)));
typedef unsigned u32x2 __attribute__((ext_vector_type(2)));

constexpr int MP = 16384, MS_ = 512, MT = MP + MS_;
constexpr int DMOD = 1024, DFF = 2816, DIN = 9224, NZ = 9216;
constexpr float EPS = 1e-6f;
constexpr float LAM_INIT = 0.2f;
constexpr float QK_C2 = 0.125f * 1.4426950408889634f;
constexpr size_t MiB = 1u << 20;
constexpr size_t WS_W1T = 1 * MiB, WS_W2T = 19 * MiB, WS_W3T = 21 * MiB, WS_W4T = 32 * MiB;
constexpr size_t WS_GATES = 38 * MiB;
constexpr size_t WS_SMALL = 39 * MiB;
constexpr size_t WS_XN = 40 * MiB;
constexpr size_t WS_Z = 73 * MiB, ZSTRIDE = 33 * MiB;
constexpr size_t WS_AO = 370 * MiB;
constexpr size_t WS_HM = 436 * MiB;
constexpr size_t WS_UB = 469 * MiB;
constexpr size_t WS_CS = WS_XN;
constexpr size_t WS_MERGED = WS_Z;
constexpr size_t WS_R = WS_Z + 1 * ZSTRIDE;
constexpr size_t WS_X1 = WS_Z + 3 * ZSTRIDE;
constexpr size_t WS_U3 = WS_Z + 5 * ZSTRIDE;
constexpr size_t WS_G3 = WS_U3 + 91 * MiB;
constexpr size_t WS_ACT = WS_G3 + 91 * MiB;
constexpr size_t WS_END = 512 * MiB;
static_assert((size_t)MT * DFF * 2 <= 91 * MiB && WS_ACT + (size_t)MT * DFF * 2 <= WS_END, "ws map");
static_assert((size_t)MT * 1024 * 2 <= 33 * MiB, "ws map");
constexpr size_t O_Y = 0, O_KP = 17301504, O_VP = 34078720, O_CP = 50855936, O_NP = 51380224, O_MP = 51382272, O_CONVP = 51382280,
                 O_KS = 51393544, O_VS = 51917832, O_CSM = 52442120, O_NS = 56636424, O_MS = 56652808, O_CONVS = 56652872, O_TOTAL = 56742984;
enum { I_XP = 0, I_XS, I_CK, I_CV, I_SC, I_SN, I_SM, I_SCONV, I_GPRE, I_WIN, I_BG, I_LQ1, I_LK1, I_LQ2, I_LK2, I_GAH, I_GMH, I_WOUT, I_GPM, I_GPF, I_WUP, I_CW, I_CB, I_WDN, I_GPFN };
struct KP { const float* in[25]; float* out; unsigned char* ws; };

DI unsigned pk2(float lo, float hi) { typedef float f2 __attribute__((ext_vector_type(2))); typedef __bf16 b2 __attribute__((ext_vector_type(2))); f2 v = {lo, hi}; b2 b = __builtin_convertvector(v, b2); return __builtin_bit_cast(unsigned, b); }
DI float bf_lo(unsigned w) { return __uint_as_float(w << 16); }
DI float bf_hi(unsigned w) { return __uint_as_float(w & 0xffff0000u); }
DI float bf2f(bf16_t v) { return __uint_as_float(((unsigned)v) << 16); }
DI float wave_sum(float v) {
#pragma unroll
  for (int o = 1; o < 64; o <<= 1) v += __shfl_xor(v, o);
  return v; }
DI float wave_max(float v) {
#pragma unroll
  for (int o = 1; o < 64; o <<= 1) v = fmaxf(v, __shfl_xor(v, o));
  return v; }
DI float sigmoidf_(float x) { return 1.0f / (1.0f + __expf(-x)); }
DI float logsig(float x) { return fminf(x, 0.f) - log1pf(expf(-fabsf(x))); }
DI f32x16 mfma32(bf16x8 a, bf16x8 b, f32x16 c) { return __builtin_amdgcn_mfma_f32_32x32x16_bf16(a, b, c, 0, 0, 0); }
DI int crow(int r, int hi) { return (r & 3) + 8 * (r >> 2) + 4 * hi; }
typedef short v4i16_t __attribute__((ext_vector_type(4)));
DI bf16x8 frag_tr(const unsigned char* piece, int lane) {
  const LAS char* p = (const LAS char*)piece + (4 * (lane >> 5) + ((lane & 15) >> 2)) * 64 + ((lane >> 4) & 1) * 32 + (lane & 3) * 8;
  const s16x4 lo = __builtin_bit_cast(s16x4, __builtin_amdgcn_ds_read_tr16_b64_v4i16((LAS v4i16_t*)p));
  const s16x4 hi = __builtin_bit_cast(s16x4, __builtin_amdgcn_ds_read_tr16_b64_v4i16((LAS v4i16_t*)(p + 512)));
  return (bf16x8){lo[0], lo[1], lo[2], lo[3], hi[0], hi[1], hi[2], hi[3]};
}
DI bf16x8 pack8(const f32x16& x, int s) {
  u32x4 p; p.x = pk2(x[8 * s], x[8 * s + 1]); p.y = pk2(x[8 * s + 2], x[8 * s + 3]); p.z = pk2(x[8 * s + 4], x[8 * s + 5]); p.w = pk2(x[8 * s + 6], x[8 * s + 7]);
  return __builtin_bit_cast(bf16x8, p);
}
DI bf16x8 cvt8(f32x4 a, f32x4 b) { u32x4 p; p.x = pk2(a[0], a[1]); p.y = pk2(a[2], a[3]); p.z = pk2(b[0], b[1]); p.w = pk2(b[2], b[3]); return __builtin_bit_cast(bf16x8, p); }

DI float block_scan_add256(float v, int lane, int wid, float* red) {
#pragma unroll
  for (int o = 1; o < 64; o <<= 1) { const float t = __shfl_up(v, o); if (lane >= o) v += t; }
  __syncthreads();
  if (lane == 63 && wid < 4) red[wid] = v;
  __syncthreads();
  float off = 0.f;
#pragma unroll
  for (int w = 0; w < 3; ++w) if (w < wid) off += red[w];
  return v + off;
}
DI float block_scan_max256(float v, int lane, int wid, float* red) {
#pragma unroll
  for (int o = 1; o < 64; o <<= 1) { const float t = __shfl_up(v, o); if (lane >= o) v = fmaxf(v, t); }
  __syncthreads();
  if (lane == 63 && wid < 4) red[wid] = v;
  __syncthreads();
  float off = -3.0e38f;
#pragma unroll
  for (int w = 0; w < 3; ++w) if (w < wid) off = fmaxf(off, red[w]);
  return fmaxf(v, off);
}

template <int MODE> struct EpiX {
  static constexpr bool PERM = true, AFTER_DRAIN = false;
  unsigned char* ws; float* out; float* R;
  DI void operator()(const pg8::f32x4 (&acc)[2][2][4][2], const pg8::Unit& u, int wr, int wc, int fr, int fq) const {
    const int row0 = u.pm * 256 + wr * 64 + fr, cin = wc * 32 + 8 * fq;
    if (MODE == 1) {
      const int seg = u.pn >> 2, colt = (u.pn & 3) * 256;
      bf16_t* zb = (bf16_t*)(ws + WS_Z + (size_t)seg * ZSTRIDE);
      float* fo = nullptr;
      if (seg == 1) fo = (u.pm < 64) ? out + O_KP : out + O_KS - (size_t)MP * 1024;
      if (seg == 2) fo = (u.pm < 64) ? out + O_VP : out + O_VS - (size_t)MP * 1024;
#pragma unroll
      for (int ai = 0; ai < 2; ++ai)
#pragma unroll
        for (int m = 0; m < 4; ++m) { const size_t row = row0 + ai * 128 + m * 16;
#pragma unroll
          for (int bj = 0; bj < 2; ++bj) { const int col = colt + bj * 128 + cin;
            f32x4 v0 = acc[ai][bj][m][0], v1 = acc[ai][bj][m][1];
            if (fo) { *(f32x4*)(fo + row * 1024 + col) = v0; *(f32x4*)(fo + row * 1024 + col + 4) = v1; }
            if (seg == 0) { v0 = v0 * QK_C2; v1 = v1 * QK_C2; }
            else if (seg == 3) { v0 = v0 * 0.0625f; v1 = v1 * 0.0625f; }
            else if (seg >= 6) {
#pragma unroll
              for (int e = 0; e < 4; ++e) { v0[e] = sigmoidf_(v0[e]); v1[e] = sigmoidf_(v1[e]); } }
            u32x4 w; w.x = pk2(v0[0], v0[1]); w.y = pk2(v0[2], v0[3]); w.z = pk2(v1[0], v1[1]); w.w = pk2(v1[2], v1[3]);
            *(u32x4*)(zb + row * 1024 + col) = w; } }
    } else if (MODE == 2) {
#pragma unroll
      for (int ai = 0; ai < 2; ++ai)
#pragma unroll
        for (int m = 0; m < 4; ++m) { const size_t row = row0 + ai * 128 + m * 16;
#pragma unroll
          for (int bj = 0; bj < 2; ++bj) { const int col = u.pn * 256 + bj * 128 + cin;
            *(f32x4*)(R + row * 1024 + col) = acc[ai][bj][m][0]; *(f32x4*)(R + row * 1024 + col + 4) = acc[ai][bj][m][1]; } }
    } else {
      const bool isg = u.pn >= 11; const int colt = (isg ? u.pn - 11 : u.pn) * 256;
      bf16_t* zb = (bf16_t*)(ws + (isg ? WS_G3 : WS_U3));
#pragma unroll
      for (int ai = 0; ai < 2; ++ai)
#pragma unroll
        for (int m = 0; m < 4; ++m) { const size_t row = row0 + ai * 128 + m * 16;
          float* co = nullptr;
          if (isg) { if (row < (size_t)MP) { const int t = (int)row & 8191; if (t >= 8190) co = out + O_CONVP + (size_t)(((int)row >> 13) * 2 + (t - 8190)) * DFF; }
                     else { const int r2 = (int)row - MP, t = r2 & 31; if (t >= 30) co = out + O_CONVS + (size_t)((r2 >> 5) * 2 + (t - 30)) * DFF; } }
#pragma unroll
          for (int bj = 0; bj < 2; ++bj) { const int col = colt + bj * 128 + cin;
            const f32x4 v0 = acc[ai][bj][m][0], v1 = acc[ai][bj][m][1];
            if (co) { *(f32x4*)(co + col) = v0; *(f32x4*)(co + col + 4) = v1; }
            u32x4 w; w.x = pk2(v0[0], v0[1]); w.y = pk2(v0[2], v0[3]); w.z = pk2(v1[0], v1[1]); w.w = pk2(v1[2], v1[3]);
            *(u32x4*)(zb + row * DFF + col) = w; } }
    }
  }
};

DI void transpose_item(const float* W, int K, int ldw, int nblk, int gate_skip, bf16_t* WT, float* scr, int item, int lane) {
  const int kb = item / nblk, nb = item % nblk, k0 = 64 * kb, n0 = 32 * nb, s0 = n0 + ((gate_skip && n0 >= 6144) ? 8 : 0);
#pragma unroll 8
  for (int i = 0; i < 32; ++i) { const int kk = 2 * i + (lane >> 5); scr[kk * 33 + (lane & 31)] = W[(size_t)(k0 + kk) * ldw + s0 + (lane & 31)]; }
  __builtin_amdgcn_s_waitcnt(0); asm volatile("" ::: "memory");
  const int c = lane & 7;
#pragma unroll
  for (int j = 0; j < 4; ++j) { const int n = (lane >> 3) + 8 * j; const float* s = scr + (8 * c) * 33 + n;
    u32x4 o; o.x = pk2(s[0 * 33], s[1 * 33]); o.y = pk2(s[2 * 33], s[3 * 33]); o.z = pk2(s[4 * 33], s[5 * 33]); o.w = pk2(s[6 * 33], s[7 * 33]);
    *(u32x4*)(WT + (size_t)(n0 + n) * K + k0 + 8 * c) = o; }
  __builtin_amdgcn_s_waitcnt(0); asm volatile("" ::: "memory");
}
DI void p0_prologue(const KP& p, unsigned char* lds, int tid, int lane, int wid) {
  float* scr = (float*)(lds + wid * 16384);
  const int gw = blockIdx.x * 8 + wid, NGW = gridDim.x * 8;
  constexpr int I1 = 16 * (NZ / 32), I2 = 16 * 32, I3 = 16 * (2 * DFF / 32), I4 = (DFF / 64) * 32;
  for (int it = gw; it < I1 + I2 + I3 + I4; it += NGW) {
    int r = it;
    if (r < I1) { transpose_item(p.in[I_WIN], 1024, DIN, NZ / 32, 1, (bf16_t*)(p.ws + WS_W1T), scr, r, lane); continue; } r -= I1;
    if (r < I2) { transpose_item(p.in[I_WOUT], 1024, 1024, 32, 0, (bf16_t*)(p.ws + WS_W2T), scr, r, lane); continue; } r -= I2;
    if (r < I3) { transpose_item(p.in[I_WUP], 1024, 2 * DFF, 2 * DFF / 32, 0, (bf16_t*)(p.ws + WS_W3T), scr, r, lane); continue; } r -= I3;
    transpose_item(p.in[I_WDN], DFF, 1024, 32, 0, (bf16_t*)(p.ws + WS_W4T), scr, r, lane);
  }
  __syncthreads();
  float* wg = (float*)lds;
  for (int i = tid; i < 8192; i += 512) wg[i] = p.in[I_WIN][(size_t)(i >> 3) * DIN + 6144 + (i & 7)];
  __syncthreads();
  const float* gpre = p.in[I_GPRE];
  bf16_t* XN = (bf16_t*)(p.ws + WS_XN); float* gates = (float*)(p.ws + WS_GATES);
  for (int row = gw; row < MT; row += NGW) {
    const float* xr = row < MP ? p.in[I_XP] + (size_t)row * 1024 : p.in[I_XS] + (size_t)(row - MP) * 1024;
    f32x4 v[4]; float ss = 0.f;
#pragma unroll
    for (int j = 0; j < 4; ++j) { v[j] = ((const f32x4*)xr)[lane + 64 * j]; ss += (v[j][0] * v[j][0] + v[j][1] * v[j][1]) + (v[j][2] * v[j][2] + v[j][3] * v[j][3]); }
    const float rstd = rsqrtf(wave_sum(ss) * (1.f / 1024.f) + EPS);
    f32x4 ga = {0.f, 0.f, 0.f, 0.f}, gb = {0.f, 0.f, 0.f, 0.f};
#pragma unroll
    for (int j = 0; j < 4; ++j) { const f32x4 gg = ((const f32x4*)gpre)[lane + 64 * j]; v[j] = v[j] * rstd * gg;
      u32x2 o; o.x = pk2(v[j][0], v[j][1]); o.y = pk2(v[j][2], v[j][3]);
      *(u32x2*)(XN + (size_t)row * 1024 + 4 * (lane + 64 * j)) = o;
#pragma unroll
      for (int e = 0; e < 4; ++e) { const f32x4* w = (const f32x4*)(wg + (4 * (lane + 64 * j) + e) * 8); ga += w[0] * v[j][e]; gb += w[1] * v[j][e]; } }
#pragma unroll
    for (int e = 0; e < 4; ++e) { ga[e] = wave_sum(ga[e]); gb[e] = wave_sum(gb[e]); }
    if (lane == 0) { *(f32x4*)(gates + (size_t)row * 8) = ga; *(f32x4*)(gates + (size_t)row * 8 + 4) = gb; }
  }
}
#define XB_TMO      128
#define XB_XCNT(j)  (256  + 64 * (j))
#define XB_XSUB(j)  (1280 + 64 * (j))
#define XB_XGEN(j)  (2304 + 64 * (j))
#define XB_TOP      3328
#define XB_TOPGEN   3392
#define XCD_BAR_WORDS 3456
#define XB_SPIN_CAP (1u << 18)

__device__ __forceinline__ unsigned xb_ld(unsigned* p)              { return __hip_atomic_load(p, __ATOMIC_RELAXED, __HIP_MEMORY_SCOPE_AGENT); }
__device__ __forceinline__ unsigned xb_add(unsigned* p, unsigned v) { return __hip_atomic_fetch_add(p, v, __ATOMIC_RELAXED, __HIP_MEMORY_SCOPE_AGENT); }
__device__ __forceinline__ unsigned xb_xcc_id() { return (unsigned)__builtin_amdgcn_s_getreg((3 << 11) | 20) & 0xFu; }
#define XB_SPIN(cond, bar) do { unsigned _sp = 0; while (cond) { __builtin_amdgcn_s_sleep(1); \
    if ((++_sp & 255u) == 0u) { if (xb_ld(&(bar)[XB_TMO])) break; if (_sp > XB_SPIN_CAP) { atomicAdd(&(bar)[XB_TMO], 1u); break; } } } } while (0)

struct XcdBarrier {
    unsigned* bar; unsigned x;
    volatile LAS unsigned* st;
};

__device__ __forceinline__ XcdBarrier xcd_barrier_post(unsigned* bar, volatile LAS unsigned* st) {
    XcdBarrier b; b.bar = bar; b.x = xb_xcc_id(); b.st = st;
    if (threadIdx.x == 0) (void)xb_add(&bar[XB_XCNT(b.x)], 1u);
    return b;
}
__device__ __forceinline__ void xcd_barrier_complete(unsigned* bar, unsigned x, unsigned& nloc, unsigned& nx) {
    const unsigned G = gridDim.x * gridDim.y * gridDim.z;
    unsigned sum, cnt, mine, sp = 0u;
    for (;;) {
        sum = 0u; cnt = 0u; mine = 0u;
#pragma unroll
        for (unsigned j = 0; j < 16; ++j) { const unsigned c = xb_ld(&bar[XB_XCNT(j)]); sum += c; cnt += (c > 0u) ? 1u : 0u; mine = (j == x) ? c : mine; }
        if (sum == G) break;
        __builtin_amdgcn_s_sleep(1);
        if ((++sp & 255u) == 0u) { if (xb_ld(&bar[XB_TMO])) break; if (sp > XB_SPIN_CAP) { atomicAdd(&bar[XB_TMO], 1u); break; } }
    }
    nloc = mine > 0u ? mine : 1u; nx = cnt > 0u ? cnt : 1u;
}

__device__ __forceinline__ void xcd_barrier(const XcdBarrier& b) {
    asm volatile("s_waitcnt vmcnt(0)" ::: "memory");
    __syncthreads();
    if (threadIdx.x == 0) {
        unsigned* bar = b.bar;
        __builtin_amdgcn_s_waitcnt(0);
        unsigned nloc = b.st[0], nx = b.st[1];
        if (nloc == 0u) { xcd_barrier_complete(bar, b.x, nloc, nx); b.st[0] = nloc; b.st[1] = nx; }
        const unsigned old = xb_add(&bar[XB_XSUB(b.x)], 1u);
        const unsigned gen = old / nloc;
        if (old + 1u == (gen + 1u) * nloc) {
            __builtin_amdgcn_fence(__ATOMIC_RELEASE, "agent");
            asm volatile("s_waitcnt vmcnt(0)" ::: "memory");
            const unsigned og = xb_add(&bar[XB_TOP], 1u);
            const unsigned tg = og / nx;
            if (og + 1u == (tg + 1u) * nx) xb_add(&bar[XB_TOPGEN], 1u);
            else XB_SPIN(xb_ld(&bar[XB_TOPGEN]) == tg, bar);
            __builtin_amdgcn_fence(__ATOMIC_ACQUIRE, "agent");
            xb_add(&bar[XB_XGEN(b.x)], 1u);
            asm volatile("s_waitcnt vmcnt(0)" ::: "memory");
        } else {
            XB_SPIN(xb_ld(&bar[XB_XGEN(b.x)]) == gen, bar);
            __builtin_amdgcn_fence(__ATOMIC_ACQUIRE, "agent");
            asm volatile("s_waitcnt vmcnt(0)" ::: "memory");
        }
    }
    __syncthreads();
}

DI float* sm_chF(const KP& p) { return (float*)(p.ws + WS_SMALL); }
DI float* sm_chM(const KP& p) { return (float*)(p.ws + WS_SMALL) + 512; }
DI float* sm_MSt(const KP& p) { return (float*)(p.ws + WS_SMALL) + 1024; }
DI float* sm_nU(const KP& p) { return (float*)(p.ws + WS_SMALL) + 2048; }
DI float* sm_nS(const KP& p) { return (float*)(p.ws + WS_SMALL) + 2048 + 65536; }

DI void mlstm_a_unit(const KP& p, int unit, unsigned char* lds, int tid, int lane, int wid) {
  const int bh = unit >> 5, c = unit & 31, b = bh >> 2, h = bh & 3;
  const int row0 = b * 8192 + c * 256;
  float* sw = (float*)lds;
  float* red = (float*)(lds + 1024);
  unsigned char* img = lds + 2048;
  const float* gates = (const float*)(p.ws + WS_GATES); const float* bg = p.in[I_BG];
  const bf16_t* KM = (const bf16_t*)(p.ws + WS_Z + 4 * ZSTRIDE); const bf16_t* VM = (const bf16_t*)(p.ws + WS_Z + 5 * ZSTRIDE);
  float lf = 0.f, ig = 0.f;
  if (tid < 256) { const float* gr = gates + (size_t)(row0 + tid) * 8; ig = gr[h] + bg[h]; lf = logsig(gr[4 + h] + bg[4 + h]); }
  const float bt = block_scan_add256(lf, lane, wid, red);
  __syncthreads();
  if (tid == 255) red[8] = bt;
  __syncthreads();
  const float F = red[8];
  const float logw = (tid < 256) ? F - bt + ig : -3.0e38f;
  const float wm = wave_max(logw);
  if (lane == 0) red[9 + wid] = wm;
  __syncthreads();
  float mloc = red[9];
#pragma unroll
  for (int w = 1; w < 8; ++w) mloc = fmaxf(mloc, red[9 + w]);
  if (tid < 256) sw[tid] = expf(logw - mloc);
  if (tid == 0) { sm_chF(p)[unit] = F; sm_chM(p)[unit] = mloc; }
  const int wr = wid >> 1, wc = wid & 1, hi = lane >> 5, r32 = lane & 31;
  f32x16 acc[2][4];
#pragma unroll
  for (int a = 0; a < 2; ++a)
#pragma unroll
    for (int q = 0; q < 4; ++q)
#pragma unroll
      for (int i = 0; i < 16; ++i) acc[a][q][i] = 0.f;
  float nacc = 0.f;
#pragma unroll 1
  for (int st = 0; st < 4; ++st) {
    __syncthreads();
#pragma unroll
    for (int i = 0; i < 8; ++i) {
      const int pid = wid * 8 + i, isK = pid >> 5, q = pid & 31, cgp = q >> 2, sg = q & 3;
      const int srow = st * 64 + sg * 16 + (lane >> 2);
      const bf16_t* src = (isK ? KM : VM) + (size_t)(row0 + srow) * 1024 + h * 256 + cgp * 32 + (lane & 3) * 8;
      u32x4 d = *(const u32x4*)src;
      if (!isK) { const float s = sw[srow];
        d.x = pk2(bf_lo(d.x) * s, bf_hi(d.x) * s); d.y = pk2(bf_lo(d.y) * s, bf_hi(d.y) * s); d.z = pk2(bf_lo(d.z) * s, bf_hi(d.z) * s); d.w = pk2(bf_lo(d.w) * s, bf_hi(d.w) * s); }
      *(u32x4*)(img + pid * 1024 + lane * 16) = d;
    }
    __syncthreads();
    if (tid < 256) {
      const int kc = tid;
#pragma unroll 8
      for (int s = 0; s < 64; ++s) nacc += sw[st * 64 + s] * bf2f(*(const bf16_t*)(img + (32 + (kc >> 5) * 4 + (s >> 4)) * 1024 + (s & 15) * 64 + (kc & 31) * 2));
    }
#pragma unroll
    for (int ks = 0; ks < 4; ++ks) {
      bf16x8 af[2], bfr[4];
#pragma unroll
      for (int a = 0; a < 2; ++a) af[a] = frag_tr(img + ((wr * 2 + a) * 4 + ks) * 1024, lane);
#pragma unroll
      for (int q = 0; q < 4; ++q) bfr[q] = frag_tr(img + (32 + (wc * 4 + q) * 4 + ks) * 1024, lane);
#pragma unroll
      for (int a = 0; a < 2; ++a)
#pragma unroll
        for (int q = 0; q < 4; ++q) acc[a][q] = mfma32(af[a], bfr[q], acc[a][q]);
    }
  }
  bf16_t* U = (bf16_t*)(p.ws + WS_UB) + (size_t)unit * 65536 + (wr * 64 + 4 * hi) * 256 + wc * 128 + r32;
  asm volatile("" : "+v"(U));
#pragma unroll
  for (int a = 0; a < 2; ++a)
#pragma unroll
    for (int q = 0; q < 4; ++q)
#pragma unroll
      for (int i = 0; i < 16; ++i) U[(a * 32 + (i & 3) + 8 * (i >> 2)) * 256 + q * 32] = (bf16_t)(pk2(acc[a][q][i], 0.f) & 0xffffu);
  if (tid < 256) sm_nU(p)[unit * 256 + tid] = nacc;
  __syncthreads();
}

DI void mlstm_scan(const KP& p, int tid) {
  const int gt = blockIdx.x * 512 + tid;
  const int bh = gt >> 14, rem = (gt & 16383) * 4;
  const bf16_t* U = (const bf16_t*)(p.ws + WS_UB); bf16_t* CS = (bf16_t*)(p.ws + WS_CS);
  const float* chF = sm_chF(p); const float* chM = sm_chM(p);
  f32x4 C = {0.f, 0.f, 0.f, 0.f}; float M = 0.f, nv = 0.f;
  const bool nthr = (gt & 16383) < 256; const int nk = gt & 255;
#pragma unroll 4
  for (int c = 0; c < 32; ++c) {
    const int un = bh * 32 + c;
    u32x2 o; o.x = pk2(C[0], C[1]); o.y = pk2(C[2], C[3]);
    *(u32x2*)(CS + (size_t)un * 65536 + rem) = o;
    const u32x2 uu = *(const u32x2*)(U + (size_t)un * 65536 + rem);
    const float F = chF[un], ml = chM[un];
    const float Mn = fmaxf(F + M, ml), a = expf(F + M - Mn), bb = expf(ml - Mn);
    if (nthr) { sm_nS(p)[un * 256 + nk] = nv; nv = a * nv + bb * sm_nU(p)[un * 256 + nk]; if (nk == 0) sm_MSt(p)[un] = M; }
    C[0] = a * C[0] + bb * bf_lo(uu.x); C[1] = a * C[1] + bb * bf_hi(uu.x); C[2] = a * C[2] + bb * bf_lo(uu.y); C[3] = a * C[3] + bb * bf_hi(uu.y);
    M = Mn;
  }
  *(f32x4*)(p.out + O_CP + (size_t)bh * 65536 + rem) = C;
  if (nthr) { p.out[O_NP + bh * 256 + nk] = nv; if (nk == 0) p.out[O_MP + bh] = M; }
}

DI void mlstm_c_unit(const KP& p, int unit, unsigned char* lds, int tid, int lane, int wid) {
  const int bh = unit >> 5, c = unit & 31, b = bh >> 2, h = bh & 3;
  const int row0 = b * 8192 + c * 256;
  float* sa = (float*)lds;
  float* smx = (float*)(lds + 1024);
  float* sbt = (float*)(lds + 2048);
  float* sinv = (float*)(lds + 3072);
  float* sn = (float*)(lds + 4096);
  float* red = (float*)(lds + 5120);
  unsigned char* img = lds + 6144;
  const float* gates = (const float*)(p.ws + WS_GATES); const float* bg = p.in[I_BG];
  const bf16_t* QM = (const bf16_t*)(p.ws + WS_Z + 3 * ZSTRIDE); const bf16_t* KM = (const bf16_t*)(p.ws + WS_Z + 4 * ZSTRIDE); const bf16_t* VM = (const bf16_t*)(p.ws + WS_Z + 5 * ZSTRIDE);
  const bf16_t* CS = (const bf16_t*)(p.ws + WS_CS) + (size_t)unit * 65536;
  const float Mc = sm_MSt(p)[unit];
  float lf = 0.f, ig = 0.f;
  if (tid < 256) { const float* gr = gates + (size_t)(row0 + tid) * 8; ig = gr[h] + bg[h]; lf = logsig(gr[4 + h] + bg[4 + h]); sn[tid] = sm_nS(p)[unit * 256 + tid]; }
  const float bt = block_scan_add256(lf, lane, wid, red);
  const float av = (tid < 256) ? ig - bt : -3.0e38f;
  __syncthreads();
  const float pm = block_scan_max256(av, lane, wid, red);
  if (tid < 256) { sa[tid] = av; smx[tid] = fmaxf(Mc, pm); sbt[tid] = bt; }
  __syncthreads();
  const int hi = lane >> 5, r32 = lane & 31, tq = wid * 32 + r32;
  const bf16_t* qrow = QM + (size_t)(row0 + tq) * 1024 + h * 256 + 8 * hi;
  f32x16 acc[8];
#pragma unroll
  for (int v = 0; v < 8; ++v)
#pragma unroll
    for (int i = 0; i < 16; ++i) acc[v][i] = 0.f;
  float nq = 0.f;
#pragma unroll 2
  for (int ks = 0; ks < 16; ++ks) {
    const u32x4 qw = *(const u32x4*)(qrow + ks * 16);
    const bf16x8 qf = __builtin_bit_cast(bf16x8, qw);
    const f32x4 n0 = *(const f32x4*)(sn + ks * 16 + 8 * hi), n1 = *(const f32x4*)(sn + ks * 16 + 8 * hi + 4);
    nq += bf_lo(qw.x) * n0[0] + bf_hi(qw.x) * n0[1] + bf_lo(qw.y) * n0[2] + bf_hi(qw.y) * n0[3] + bf_lo(qw.z) * n1[0] + bf_hi(qw.z) * n1[1] + bf_lo(qw.w) * n1[2] + bf_hi(qw.w) * n1[3];
#pragma unroll
    for (int v = 0; v < 8; ++v) { const bf16x8 cf = *(const bf16x8*)(CS + (size_t)(v * 32 + r32) * 256 + ks * 16 + 8 * hi); acc[v] = mfma32(qf, cf, acc[v]); }
  }
  nq += __shfl_xor(nq, 32);
  {
#pragma unroll
    for (int i = 0; i < 16; ++i) { const float wi = expf(Mc - smx[wid * 32 + crow(i, hi)]);
#pragma unroll
      for (int v = 0; v < 8; ++v) acc[v][i] *= wi; }
  }
  const float mxq = smx[tq];
  float dsum = 0.f;
#pragma unroll 1
  for (int j = 0; j < 8; ++j) {
    unsigned char* buf = img + (j & 1) * 16384;
#pragma unroll
    for (int i = 0; i < 2; ++i) {
      const int pid = wid * 2 + i, cgp = pid >> 1, sg = pid & 1;
      const bf16_t* src = VM + (size_t)(row0 + j * 32 + sg * 16 + (lane >> 2)) * 1024 + h * 256 + cgp * 32 + (lane & 3) * 8;
      *(u32x4*)(buf + pid * 1024 + lane * 16) = *(const u32x4*)src;
    }
    __syncthreads();
    if (j <= wid) {
      f32x16 st;
#pragma unroll
      for (int i = 0; i < 16; ++i) st[i] = 0.f;
      const bf16_t* krow = KM + (size_t)(row0 + j * 32 + r32) * 1024 + h * 256 + 8 * hi;
#pragma unroll 4
      for (int ks = 0; ks < 16; ++ks) { const bf16x8 kf = *(const bf16x8*)(krow + ks * 16); const bf16x8 qf = *(const bf16x8*)(qrow + ks * 16); st = mfma32(kf, qf, st); }
#pragma unroll
      for (int i = 0; i < 16; ++i) { const int s = j * 32 + crow(i, hi);
        const float w = (s <= tq) ? expf(sa[s] - mxq) : 0.f;
        st[i] *= w; dsum += st[i]; }
      const bf16x8 pa0 = pack8(st, 0), pa1 = pack8(st, 1);
#pragma unroll
      for (int v = 0; v < 8; ++v) { acc[v] = mfma32(pa0, frag_tr(buf + (v * 2 + 0) * 1024, lane), acc[v]); acc[v] = mfma32(pa1, frag_tr(buf + (v * 2 + 1) * 1024, lane), acc[v]); }
    }
  }
  dsum += __shfl_xor(dsum, 32);
  {
    const float den = dsum + expf(Mc - mxq) * nq;
    const float dn = fmaxf(fabsf(den), expf(-(sbt[tq] + mxq)));
    if (hi == 0) sinv[tq] = 1.0f / dn;
  }
  __syncthreads();
  bf16_t* HM = (bf16_t*)(p.ws + WS_HM) + (size_t)(row0 + wid * 32 + 4 * hi) * 1024 + h * 256 + r32;
  asm volatile("" : "+v"(HM));
#pragma unroll
  for (int i = 0; i < 16; ++i) { const float inv = sinv[wid * 32 + crow(i, hi)];
#pragma unroll
    for (int v = 0; v < 8; ++v) HM[((i & 3) + 8 * (i >> 2)) * 1024 + v * 32] = (bf16_t)(pk2(acc[v][i] * inv, 0.f) & 0xffffu); }
  __syncthreads();
}

DI void mlstm_sample_unit(const KP& p, int unit, unsigned char* lds, int tid, int lane, int wid) {
  const int vs = unit & 7, h = (unit >> 3) & 3, b = unit >> 5;
  const int row0 = MP + b * 32;
  constexpr int LD = 257;
  float* qs = (float*)lds;
  float* ks = qs + 32 * LD;
  float* Cs = ks + 32 * LD;
  float* vsl = Cs + 32 * LD;
  float* S = vsl + 32 * 33;
  float* sc = S + 32 * 33;
  const bf16_t* QM = (const bf16_t*)(p.ws + WS_Z + 3 * ZSTRIDE); const bf16_t* KM = (const bf16_t*)(p.ws + WS_Z + 4 * ZSTRIDE); const bf16_t* VM = (const bf16_t*)(p.ws + WS_Z + 5 * ZSTRIDE);
  const float* C0 = p.in[I_SC] + ((size_t)(b * 4 + h) * 256 + vs * 32) * 256;
  const float* n0 = p.in[I_SN] + (size_t)(b * 4 + h) * 256;
  const float m0 = p.in[I_SM][b * 4 + h];
  for (int i = tid; i < 32 * 256; i += 512) { const int t = i >> 8, k = i & 255;
    qs[t * LD + k] = bf2f(QM[(size_t)(row0 + t) * 1024 + h * 256 + k]); ks[t * LD + k] = bf2f(KM[(size_t)(row0 + t) * 1024 + h * 256 + k]); Cs[t * LD + k] = C0[t * 256 + k]; }
  for (int i = tid; i < 1024; i += 512) { const int t = i >> 5, v = i & 31; vsl[t * 33 + v] = bf2f(VM[(size_t)(row0 + t) * 1024 + h * 256 + vs * 32 + v]); }
  if (tid == 0) {
    const float* gates = (const float*)(p.ws + WS_GATES); const float* bg = p.in[I_BG];
    float bc = 0.f, pmx = -3.0e38f;
    for (int t = 0; t < 32; ++t) { const float* gr = gates + (size_t)(row0 + t) * 8; const float ig = gr[h] + bg[h]; bc += logsig(gr[4 + h] + bg[4 + h]);
      sc[t] = bc; sc[32 + t] = ig; pmx = fmaxf(pmx, ig - bc); const float mt = bc + fmaxf(m0, pmx); sc[64 + t] = mt; sc[96 + t] = expf(bc + m0 - mt); }
    const float gl = bc; float mn = gl + m0;
    for (int t = 0; t < 32; ++t) mn = fmaxf(mn, gl - sc[t] + sc[32 + t]);
    for (int t = 0; t < 32; ++t) sc[128 + t] = expf(gl - sc[t] + sc[32 + t] - mn);
    sc[192] = expf(gl + m0 - mn); sc[193] = mn;
  }
  __syncthreads();
  for (int i = tid; i < 1024; i += 512) { const int t = i >> 5, s = i & 31; float d = 0.f;
    if (s <= t) {
#pragma unroll 8
      for (int k = 0; k < 256; ++k) d += qs[t * LD + k] * ks[s * LD + k];
      d *= expf(sc[t] - sc[s] + sc[32 + s] - sc[64 + t]); }
    S[t * 33 + s] = d; }
  __syncthreads();
  if (tid < 32) { const int t = tid; float ds = 0.f, nqv = 0.f;
    for (int s = 0; s < 32; ++s) ds += S[t * 33 + s];
    for (int k = 0; k < 256; ++k) nqv += n0[k] * qs[t * LD + k];
    const float den = ds + sc[96 + t] * nqv;
    sc[160 + t] = 1.0f / fmaxf(fabsf(den), expf(-sc[64 + t])); }
  __syncthreads();
  bf16_t* HM = (bf16_t*)(p.ws + WS_HM);
  for (int i = tid; i < 1024; i += 512) { const int t = i >> 5, v = i & 31; float a = 0.f, c2 = 0.f;
#pragma unroll 8
    for (int s = 0; s < 32; ++s) a += S[t * 33 + s] * vsl[s * 33 + v];
#pragma unroll 8
    for (int k = 0; k < 256; ++k) c2 += Cs[v * LD + k] * qs[t * LD + k];
    const float hv = (a + sc[96 + t] * c2) * sc[160 + t];
    HM[(size_t)(row0 + t) * 1024 + h * 256 + vs * 32 + v] = (bf16_t)(pk2(hv, 0.f) & 0xffffu); }
  const float wcf = sc[192];
  { const int k = tid & 255, vh = tid >> 8;
    float* Co = p.out + O_CSM + ((size_t)(b * 4 + h) * 256 + vs * 32) * 256;
    for (int v = vh * 16; v < vh * 16 + 16; ++v) { float a = wcf * Cs[v * LD + k];
#pragma unroll 8
      for (int s = 0; s < 32; ++s) a += sc[128 + s] * vsl[s * 33 + v] * ks[s * LD + k];
      Co[v * 256 + k] = a; }
    if (vs == 0 && tid < 256) { float a = wcf * n0[k];
      for (int s = 0; s < 32; ++s) a += sc[128 + s] * ks[s * LD + k];
      p.out[O_NS + (b * 4 + h) * 256 + k] = a; if (k == 0) p.out[O_MS + b * 4 + h] = sc[193]; } }
  __syncthreads();
}

DI float lam_value(const KP& p, int lane) {
  const float a = wave_sum(p.in[I_LQ1][lane] * p.in[I_LK1][lane]), b = wave_sum(p.in[I_LQ2][lane] * p.in[I_LK2][lane]);
  return expf(a) - expf(b) + LAM_INIT;
}
DI void attn_sample_unit(const KP& p, int unit, unsigned char* lds, int tid, int lane, int wid) {
  const int b = unit >> 3, h = unit & 7, hi = lane >> 5, r32 = lane & 31;
  float* sm = (float*)lds;
  float* sl = sm + 512;
  float* Ored = sl + 512;
  const float lam = lam_value(p, lane);
  for (int i = tid; i < 4096; i += 512) Ored[i] = 0.f;
  const bf16_t* QA = (const bf16_t*)(p.ws + WS_Z);
  bf16x8 qf[2][4];
#pragma unroll
  for (int m = 0; m < 2; ++m)
#pragma unroll
    for (int d0 = 0; d0 < 4; ++d0) qf[m][d0] = *(const bf16x8*)(QA + (size_t)(MP + b * 32 + r32) * 1024 + h * 128 + m * 64 + d0 * 16 + 8 * hi);
  const float* ck = p.in[I_CK] + ((size_t)b * 2048 * 8 + h) * 128; const float* cv = p.in[I_CV] + ((size_t)b * 2048 * 8 + h) * 128;
  const float* nk = p.out + O_KS + ((size_t)b * 32 * 8 + h) * 128; const float* nv = p.out + O_VS + ((size_t)b * 32 * 8 + h) * 128;
  float mr[2] = {-1.0e30f, -1.0e30f}, lr[2] = {0.f, 0.f};
#pragma unroll 1
  for (int j = wid; j < 65; j += 8) {
    const float* kb = (j < 64 ? ck + (size_t)j * 32 * 1024 : nk) + (size_t)r32 * 1024 + 8 * hi;
#pragma unroll
    for (int m = 0; m < 2; ++m) {
      f32x16 s;
#pragma unroll
      for (int i = 0; i < 16; ++i) s[i] = 0.f;
#pragma unroll
      for (int d0 = 0; d0 < 4; ++d0) { const f32x4 x0 = *(const f32x4*)(kb + m * 64 + d0 * 16), x1 = *(const f32x4*)(kb + m * 64 + d0 * 16 + 4); s = mfma32(cvt8(x0, x1), qf[m][d0], s); }
      float mx = s[0];
#pragma unroll
      for (int i = 1; i < 16; ++i) mx = fmaxf(mx, s[i]);
      mx = fmaxf(mx, __shfl_xor(mx, 32));
      const float mn = fmaxf(mr[m], mx); float ls = 0.f;
#pragma unroll
      for (int i = 0; i < 16; ++i) ls += exp2f(s[i] - mn);
      lr[m] = lr[m] * exp2f(mr[m] - mn) + ls; mr[m] = mn;
    }
  }
#pragma unroll
  for (int m = 0; m < 2; ++m) { lr[m] += __shfl_xor(lr[m], 32); if (hi == 0) { sm[(m * 8 + wid) * 32 + r32] = mr[m]; sl[(m * 8 + wid) * 32 + r32] = lr[m]; } }
  __syncthreads();
  float Mx[2], Li[2];
#pragma unroll
  for (int m = 0; m < 2; ++m) { float mm = -1.0e30f;
#pragma unroll
    for (int w = 0; w < 8; ++w) mm = fmaxf(mm, sm[(m * 8 + w) * 32 + r32]);
    float ll = 0.f;
#pragma unroll
    for (int w = 0; w < 8; ++w) ll += sl[(m * 8 + w) * 32 + r32] * exp2f(sm[(m * 8 + w) * 32 + r32] - mm);
    Mx[m] = mm; Li[m] = 1.0f / ll; }
  f32x16 o[4];
#pragma unroll
  for (int d = 0; d < 4; ++d)
#pragma unroll
    for (int i = 0; i < 16; ++i) o[d][i] = 0.f;
#pragma unroll 1
  for (int j = wid; j < 65; j += 8) {
    const float* kb = (j < 64 ? ck + (size_t)j * 32 * 1024 : nk) + (size_t)r32 * 1024 + 8 * hi;
    const float* vb = (j < 64 ? cv + (size_t)j * 32 * 1024 : nv) + r32;
    f32x16 s[2];
#pragma unroll
    for (int m = 0; m < 2; ++m) {
#pragma unroll
      for (int i = 0; i < 16; ++i) s[m][i] = 0.f;
#pragma unroll
      for (int d0 = 0; d0 < 4; ++d0) { const f32x4 x0 = *(const f32x4*)(kb + m * 64 + d0 * 16), x1 = *(const f32x4*)(kb + m * 64 + d0 * 16 + 4); s[m] = mfma32(cvt8(x0, x1), qf[m][d0], s[m]); }
    }
    f32x16 a;
#pragma unroll
    for (int i = 0; i < 16; ++i) a[i] = exp2f(s[0][i] - Mx[0]) * Li[0] - lam * (exp2f(s[1][i] - Mx[1]) * Li[1]);
#pragma unroll
    for (int s2 = 0; s2 < 2; ++s2) {
      const bf16x8 pa = pack8(a, s2);
#pragma unroll
      for (int d = 0; d < 4; ++d) {
        float x[8];
#pragma unroll
        for (int jj = 0; jj < 8; ++jj) x[jj] = vb[(size_t)(16 * s2 + 8 * (jj >> 2) + 4 * hi + (jj & 3)) * 1024 + d * 32];
        const bf16x8 vf = cvt8((f32x4){x[0], x[1], x[2], x[3]}, (f32x4){x[4], x[5], x[6], x[7]});
        o[d] = mfma32(pa, vf, o[d]);
      }
    }
  }
#pragma unroll
  for (int d = 0; d < 4; ++d)
#pragma unroll
    for (int i = 0; i < 16; ++i) atomicAdd(&Ored[crow(i, hi) * 128 + d * 32 + r32], o[d][i]);
  __syncthreads();
  { const int q = tid >> 4, d8 = (tid & 15) * 8; const float* s = Ored + q * 128 + d8;
    u32x4 w; w.x = pk2(s[0], s[1]); w.y = pk2(s[2], s[3]); w.z = pk2(s[4], s[5]); w.w = pk2(s[6], s[7]);
    bf16_t* AO = (bf16_t*)(p.ws + WS_AO) + (size_t)(MP + b * 32 + q) * 2048 + h * 128 + d8;
    *(u32x4*)AO = w; *(u32x4*)(AO + 1024) = (u32x4){0u, 0u, 0u, 0u}; }
  __syncthreads();
}

DI void merge_rows(const KP& p, int lane, int wid) {
  const float lam = lam_value(p, lane);
  const bf16_t* AO = (const bf16_t*)(p.ws + WS_AO); const bf16_t* HM = (const bf16_t*)(p.ws + WS_HM);
  const bf16_t* OM = (const bf16_t*)(p.ws + WS_Z + 6 * ZSTRIDE); const bf16_t* GA = (const bf16_t*)(p.ws + WS_Z + 7 * ZSTRIDE); const bf16_t* GM = (const bf16_t*)(p.ws + WS_Z + 8 * ZSTRIDE);
  bf16_t* MG = (bf16_t*)(p.ws + WS_MERGED);
  const int c0 = lane * 16;
  float gah[16], gmh[16];
#pragma unroll
  for (int e = 0; e < 16; ++e) { gah[e] = p.in[I_GAH][(c0 + e) & 127] * (1.0f - LAM_INIT); gmh[e] = p.in[I_GMH][c0 + e]; }
  for (int row = blockIdx.x * 8 + wid; row < MT; row += gridDim.x * 8) {
    float a[16], hm[16], om[16], ga[16], gm[16];
#define LD16(dst, ptr) do { const u32x4 w0_ = *(const u32x4*)(ptr), w1_ = *(const u32x4*)((ptr) + 8); \
      dst[0] = bf_lo(w0_.x); dst[1] = bf_hi(w0_.x); dst[2] = bf_lo(w0_.y); dst[3] = bf_hi(w0_.y); dst[4] = bf_lo(w0_.z); dst[5] = bf_hi(w0_.z); dst[6] = bf_lo(w0_.w); dst[7] = bf_hi(w0_.w); \
      dst[8] = bf_lo(w1_.x); dst[9] = bf_hi(w1_.x); dst[10] = bf_lo(w1_.y); dst[11] = bf_hi(w1_.y); dst[12] = bf_lo(w1_.z); dst[13] = bf_hi(w1_.z); dst[14] = bf_lo(w1_.w); dst[15] = bf_hi(w1_.w); } while (0)
    { float o2[16]; LD16(a, AO + (size_t)row * 2048 + c0); LD16(o2, AO + (size_t)row * 2048 + 1024 + c0);
#pragma unroll
      for (int e = 0; e < 16; ++e) a[e] -= lam * o2[e]; }
    LD16(hm, HM + (size_t)row * 1024 + c0); LD16(om, OM + (size_t)row * 1024 + c0); LD16(ga, GA + (size_t)row * 1024 + c0); LD16(gm, GM + (size_t)row * 1024 + c0);
    float sa = 0.f, sh = 0.f;
#pragma unroll
    for (int e = 0; e < 16; ++e) { sa += a[e] * a[e]; sh += hm[e] * hm[e]; }
    sa += __shfl_xor(sa, 1); sa += __shfl_xor(sa, 2); sa += __shfl_xor(sa, 4);
    sh += __shfl_xor(sh, 1); sh += __shfl_xor(sh, 2); sh += __shfl_xor(sh, 4); sh += __shfl_xor(sh, 8);
    const float ra = rsqrtf(sa * (1.f / 128.f) + EPS), rh = rsqrtf(sh * (1.f / 256.f) + EPS);
    float o[16];
#pragma unroll
    for (int e = 0; e < 16; ++e) o[e] = ga[e] * (a[e] * ra * gah[e]) + gm[e] * (om[e] * (hm[e] * rh * gmh[e]));
    u32x4 w0, w1; w0.x = pk2(o[0], o[1]); w0.y = pk2(o[2], o[3]); w0.z = pk2(o[4], o[5]); w0.w = pk2(o[6], o[7]); w1.x = pk2(o[8], o[9]); w1.y = pk2(o[10], o[11]); w1.z = pk2(o[12], o[13]); w1.w = pk2(o[14], o[15]);
    *(u32x4*)(MG + (size_t)row * 1024 + c0) = w0; *(u32x4*)(MG + (size_t)row * 1024 + c0 + 8) = w1;
  }
}
DI void norm_rows(const KP& p, int lane, int wid) {
  const float* R = (const float*)(p.ws + WS_R); float* X1 = (float*)(p.ws + WS_X1); bf16_t* XN = (bf16_t*)(p.ws + WS_XN);
  for (int row = blockIdx.x * 8 + wid; row < MT; row += gridDim.x * 8) {
    const float* xr = row < MP ? p.in[I_XP] + (size_t)row * 1024 : p.in[I_XS] + (size_t)(row - MP) * 1024;
    f32x4 r[4], x[4]; float ss = 0.f;
#pragma unroll
    for (int j = 0; j < 4; ++j) { r[j] = ((const f32x4*)(R + (size_t)row * 1024))[lane + 64 * j]; x[j] = ((const f32x4*)xr)[lane + 64 * j]; ss += (r[j][0] * r[j][0] + r[j][1] * r[j][1]) + (r[j][2] * r[j][2] + r[j][3] * r[j][3]); }
    const float rs = rsqrtf(wave_sum(ss) * (1.f / 1024.f) + EPS); float s2 = 0.f;
#pragma unroll
    for (int j = 0; j < 4; ++j) { x[j] = x[j] + r[j] * rs * ((const f32x4*)p.in[I_GPM])[lane + 64 * j]; ((f32x4*)(X1 + (size_t)row * 1024))[lane + 64 * j] = x[j];
      s2 += (x[j][0] * x[j][0] + x[j][1] * x[j][1]) + (x[j][2] * x[j][2] + x[j][3] * x[j][3]); }
    const float r2 = rsqrtf(wave_sum(s2) * (1.f / 1024.f) + EPS);
#pragma unroll
    for (int j = 0; j < 4; ++j) { const f32x4 v = x[j] * r2 * ((const f32x4*)p.in[I_GPF])[lane + 64 * j]; u32x2 o; o.x = pk2(v[0], v[1]); o.y = pk2(v[2], v[3]);
      *(u32x2*)(XN + (size_t)row * 1024 + 4 * (lane + 64 * j)) = o; }
  }
}
DI void final_rows(const KP& p, int lane, int wid) {
  const float* R = (const float*)(p.ws + WS_R); const float* X1 = (const float*)(p.ws + WS_X1);
  for (int row = blockIdx.x * 8 + wid; row < MT; row += gridDim.x * 8) {
    f32x4 r[4]; float ss = 0.f;
#pragma unroll
    for (int j = 0; j < 4; ++j) { r[j] = ((const f32x4*)(R + (size_t)row * 1024))[lane + 64 * j]; ss += (r[j][0] * r[j][0] + r[j][1] * r[j][1]) + (r[j][2] * r[j][2] + r[j][3] * r[j][3]); }
    const float rs = rsqrtf(wave_sum(ss) * (1.f / 1024.f) + EPS);
#pragma unroll
    for (int j = 0; j < 4; ++j) ((f32x4*)(p.out + O_Y + (size_t)row * 1024))[lane + 64 * j] = ((const f32x4*)(X1 + (size_t)row * 1024))[lane + 64 * j] + r[j] * rs * ((const f32x4*)p.in[I_GPFN])[lane + 64 * j];
  }
}
DI float gelu_tanh(float x) { const float z = 0.7978845608028654f * (x + 0.044715f * x * x * x); const float t = 1.0f - 2.0f / (__expf(2.0f * z) + 1.0f); return 0.5f * x * (1.0f + t); }
DI void act_phase(const KP& p, int tid) {
  const bf16_t* U3 = (const bf16_t*)(p.ws + WS_U3); const bf16_t* G3 = (const bf16_t*)(p.ws + WS_G3); bf16_t* ACT = (bf16_t*)(p.ws + WS_ACT);
  const float* cw = p.in[I_CW]; const float* cb = p.in[I_CB]; const float* sconv = p.in[I_SCONV];
  constexpr int CPR = DFF / 8;
  for (size_t it = (size_t)blockIdx.x * 512 + tid; it < (size_t)MT * CPR; it += (size_t)gridDim.x * 512) {
    const int row = (int)(it / CPR), c0 = (int)(it % CPR) * 8;
    int t, bs = -1; if (row < MP) t = row & 8191; else { t = (row - MP) & 31; bs = (row - MP) >> 5; }
    float g[3][8];
#pragma unroll
    for (int j = 0; j < 3; ++j) {
      const int tt = t + j - 2;
      if (tt >= 0) { const u32x4 w = *(const u32x4*)(G3 + (size_t)(row + j - 2) * DFF + c0);
        g[j][0] = bf_lo(w.x); g[j][1] = bf_hi(w.x); g[j][2] = bf_lo(w.y); g[j][3] = bf_hi(w.y); g[j][4] = bf_lo(w.z); g[j][5] = bf_hi(w.z); g[j][6] = bf_lo(w.w); g[j][7] = bf_hi(w.w); }
      else if (bs >= 0) { const float* s = sconv + (size_t)(bs * 2 + (tt + 2)) * DFF + c0;
#pragma unroll
        for (int e = 0; e < 8; ++e) g[j][e] = s[e]; }
      else {
#pragma unroll
        for (int e = 0; e < 8; ++e) g[j][e] = 0.f; }
    }
    const u32x4 uw = *(const u32x4*)(U3 + (size_t)row * DFF + c0);
    float u[8] = {bf_lo(uw.x), bf_hi(uw.x), bf_lo(uw.y), bf_hi(uw.y), bf_lo(uw.z), bf_hi(uw.z), bf_lo(uw.w), bf_hi(uw.w)};
    float o[8];
#pragma unroll
    for (int e = 0; e < 8; ++e) { const float gc = cb[c0 + e] + cw[c0 + e] * g[0][e] + cw[DFF + c0 + e] * g[1][e] + cw[2 * DFF + c0 + e] * g[2][e]; o[e] = gelu_tanh(gc) * u[e]; }
    u32x4 w; w.x = pk2(o[0], o[1]); w.y = pk2(o[2], o[3]); w.z = pk2(o[4], o[5]); w.w = pk2(o[6], o[7]);
    *(u32x4*)(ACT + (size_t)row * DFF + c0) = w;
  }
}

#ifndef PROBE_MA
#define PROBE_MA 1
#endif
#ifndef PROBE_S
#define PROBE_S 1
#endif
#ifndef PROBE_MC
#define PROBE_MC 1
#endif
#ifndef PROBE_ROW
#define PROBE_ROW 1
#endif
#ifndef PROBE_SYNC
#define PROBE_SYNC 1
#endif
constexpr int LDS_BYTES = 147456;
__global__ void __launch_bounds__(512, 2) fwd_megakernel(KP p) {
  extern __shared__ __attribute__((aligned(16))) unsigned char lds[];
  cg::grid_group grid = cg::this_grid();
  int tid = threadIdx.x, lane = tid & 63, wid = __builtin_amdgcn_readfirstlane(tid >> 6);
  const int G = gridDim.x, bx = blockIdx.x;
  volatile LAS unsigned* xst = (volatile LAS unsigned*)((LAS unsigned char*)lds + 131072 + 64);
  if (tid < 4) xst[tid] = 0u;
  __syncthreads();
  const XcdBarrier xbar = xcd_barrier_post((unsigned*)p.ws, xst);
#define RELAUNDER() do { tid = threadIdx.x; asm volatile("" : "+v"(tid)); lane = tid & 63; wid = __builtin_amdgcn_readfirstlane(tid >> 6); } while (0)
#ifndef SK_P0
  for (int rep_ = 0; rep_ < PROBE_ROW; ++rep_) { p0_prologue(p, lds, tid, lane, wid); __syncthreads(); }
#endif
  for (int rep_ = 0; rep_ < PROBE_SYNC; ++rep_) grid.sync(); RELAUNDER();
  { pg8::Gemm g{(const bf16_t*)(p.ws + WS_XN), (const bf16_t*)(p.ws + WS_W1T), MT, NZ, 1024}; pg8::StaticOrder S; S.init(MT, NZ, G, bx);
    EpiX<1> E{p.ws, p.out, nullptr};
    pg8::gemm_phase<EpiX<1>, pg8::StaticOrder, true, true>((LAS unsigned char*)lds, g, S, E); }
  for (int rep_ = 0; rep_ < PROBE_SYNC; ++rep_) xcd_barrier(xbar); RELAUNDER();
#ifndef SK_MA
  for (int rep_ = 0; rep_ < PROBE_MA; ++rep_) for (int u = bx; u < 256; u += G) mlstm_a_unit(p, u, lds, tid, lane, wid);
#endif
  for (int rep_ = 0; rep_ < PROBE_S; ++rep_) for (int u = bx; u < 128 + 512; u += G) {
#ifndef SK_AS
    if (u < 128) attn_sample_unit(p, u, lds, tid, lane, wid);
#endif
#ifndef SK_MS
    if (u >= 128) mlstm_sample_unit(p, u - 128, lds, tid, lane, wid);
#endif
  }
  for (int rep_ = 0; rep_ < PROBE_SYNC; ++rep_) xcd_barrier(xbar); RELAUNDER();
#ifndef SK_SC
  if (bx < 256) mlstm_scan(p, tid);
#endif
  for (int rep_ = 0; rep_ < PROBE_SYNC; ++rep_) xcd_barrier(xbar); RELAUNDER();
#ifndef SK_MC
  for (int rep_ = 0; rep_ < PROBE_MC; ++rep_) for (int u = bx; u < 256; u += G) mlstm_c_unit(p, u, lds, tid, lane, wid);
#endif
  { const attn_body::AttnTensors AT{(const attn_body::bf16*)(p.ws + WS_Z), (const attn_body::bf16*)(p.ws + WS_Z + ZSTRIDE), (const attn_body::bf16*)(p.ws + WS_Z + 2 * ZSTRIDE), (attn_body::bf16*)(p.ws + WS_AO)};
    const attn_body::StaticOrder S(G, bx);
    attn_body::attn_phase<attn_body::StaticOrder>((char*)lds, AT, S); }
  for (int rep_ = 0; rep_ < PROBE_SYNC; ++rep_) xcd_barrier(xbar); RELAUNDER();
#ifndef SK_MG
  for (int rep_ = 0; rep_ < PROBE_ROW; ++rep_) merge_rows(p, lane, wid);
#endif
  for (int rep_ = 0; rep_ < PROBE_SYNC; ++rep_) xcd_barrier(xbar); RELAUNDER();
  { pg8::Gemm g{(const bf16_t*)(p.ws + WS_MERGED), (const bf16_t*)(p.ws + WS_W2T), MT, 1024, 1024}; pg8::StaticOrder S; S.init(MT, 1024, G, bx);
    EpiX<2> E{p.ws, p.out, (float*)(p.ws + WS_R)};
    pg8::gemm_phase<EpiX<2>, pg8::StaticOrder, true, true>((LAS unsigned char*)lds, g, S, E); }
  for (int rep_ = 0; rep_ < PROBE_SYNC; ++rep_) xcd_barrier(xbar); RELAUNDER();
  for (int rep_ = 0; rep_ < PROBE_ROW; ++rep_) norm_rows(p, lane, wid);
  for (int rep_ = 0; rep_ < PROBE_SYNC; ++rep_) xcd_barrier(xbar); RELAUNDER();
  { pg8::Gemm g{(const bf16_t*)(p.ws + WS_XN), (const bf16_t*)(p.ws + WS_W3T), MT, 2 * DFF, 1024}; pg8::StaticOrder S; S.init(MT, 2 * DFF, G, bx);
    EpiX<3> E{p.ws, p.out, nullptr};
    pg8::gemm_phase<EpiX<3>, pg8::StaticOrder, true, true>((LAS unsigned char*)lds, g, S, E); }
  for (int rep_ = 0; rep_ < PROBE_SYNC; ++rep_) xcd_barrier(xbar); RELAUNDER();
#ifndef SK_ACT
  for (int rep_ = 0; rep_ < PROBE_ROW; ++rep_) act_phase(p, tid);
#endif
  for (int rep_ = 0; rep_ < PROBE_SYNC; ++rep_) xcd_barrier(xbar); RELAUNDER();
  { pg8::Gemm g{(const bf16_t*)(p.ws + WS_ACT), (const bf16_t*)(p.ws + WS_W4T), MT, 1024, DFF}; pg8::StaticOrder S; S.init(MT, 1024, G, bx);
    EpiX<2> E{p.ws, p.out, (float*)(p.ws + WS_R)};
    pg8::gemm_phase<EpiX<2>, pg8::StaticOrder, true, true>((LAS unsigned char*)lds, g, S, E); }
  for (int rep_ = 0; rep_ < PROBE_SYNC; ++rep_) xcd_barrier(xbar); RELAUNDER();
  for (int rep_ = 0; rep_ < PROBE_ROW; ++rep_) final_rows(p, lane, wid);
}

extern "C" void kernel_launch(void* const* d_in, const int* in_sizes, int n_in, void* d_out, int out_size, void* d_ws, size_t ws_size, hipStream_t stream) {
  static int grid = 0;
  if (grid == 0) {
    if (n_in != 25 || (size_t)out_size != O_TOTAL || ws_size < WS_END) { fprintf(stderr, "kernel_launch: unexpected shapes: n_in %d out %d ws %zu\n", n_in, out_size, ws_size); grid = -1; return; }
    int dev = 0, cus = 0, per_cu = 0;
    (void)hipGetDevice(&dev); (void)hipDeviceGetAttribute(&cus, hipDeviceAttributeMultiprocessorCount, dev);
    if (hipFuncSetAttribute((const void*)fwd_megakernel, hipFuncAttributeMaxDynamicSharedMemorySize, LDS_BYTES) != hipSuccess) { fprintf(stderr, "kernel_launch: hipFuncSetAttribute failed\n"); grid = -1; return; }
    if (hipOccupancyMaxActiveBlocksPerMultiprocessor(&per_cu, (const void*)fwd_megakernel, 512, LDS_BYTES) != hipSuccess || per_cu < 1) { fprintf(stderr, "kernel_launch: occupancy query says %d\n", per_cu); per_cu = 1; }
    (void)hipGetLastError();
    grid = cus;
    if (grid > 256) grid = 256;
  }
  if (grid < 0) return;
  if (hipMemsetAsync(d_ws, 0, 16384, stream) != hipSuccess) { fprintf(stderr, "kernel_launch: memset failed\n"); return; }
  KP p{};
  for (int i = 0; i < 25; ++i) p.in[i] = (const float*)d_in[i];
  p.out = (float*)d_out; p.ws = (unsigned char*)d_ws;
  void* args[] = {&p};
  hipError_t e = hipLaunchCooperativeKernel((const void*)fwd_megakernel, dim3(grid), dim3(512), args, LDS_BYTES, stream);
  if (e != hipSuccess) fprintf(stderr, "cooperative launch failed: %s (grid %d)\n", hipGetErrorString(e), grid);
}
```
